# Optimizing an MI355X kernel written in HIP

```python
import math
import jax, jax.numpy as jnp
from jax import lax
import numpy as np

D_MODEL = 2048
BATCH = 1
SEQ = 8192
DEPTH = 1
DEC_BATCH = 2
DEC_SEQ = 8192
PAST_LEN = 128

MIX_WIDTH = D_MODEL
RET_WIDTH = MIX_WIDTH // 2
CONV_WIDTH = MIX_WIDTH - RET_WIDTH
RET_HEADS = 8
RET_HEAD_DIM = RET_WIDTH // RET_HEADS
CONV_GROUPS = 8
CHUNK = 128
ROPE_BASE = 10000.0
CONV_K = 3
IN_PROJ_WIDTH = 4 * RET_WIDTH + 3 * CONV_WIDTH

PEER_HEADS = 8
PEER_N_KEYS = 128
PEER_N_EXPERTS = PEER_N_KEYS * PEER_N_KEYS
PEER_QUERY_DIM = 256
PEER_HALF = PEER_QUERY_DIM // 2
PEER_TOPK = 16
TOKEN_BLOCK = 128

LN_EPS = 1e-5
GN_EPS = 1e-6
DEEPNORM_ALPHA = (2.0 * DEPTH) ** 0.25
DEEPNORM_BETA = (8.0 * DEPTH) ** -0.25

kernel_name = "hymba_retention_shortconv_peer_encoder"


def layer_norm(x, g, b):
    xf = x.astype(jnp.float32)
    mu = jnp.mean(xf, axis=-1, keepdims=True)
    var = jnp.mean(jnp.square(xf - mu), axis=-1, keepdims=True)
    y = (xf - mu) * lax.rsqrt(var + LN_EPS) * g.astype(jnp.float32) + b.astype(jnp.float32)
    return y.astype(x.dtype)


def rotary(x):
    s, dh = x.shape[1], x.shape[-1]
    inv = ROPE_BASE ** (-jnp.arange(0, dh, 2, dtype=jnp.float32) / dh)
    ang = jnp.arange(s, dtype=jnp.float32)[:, None] * inv[None, :]
    cos = jnp.cos(ang)[None, :, None, :]
    sin = jnp.sin(ang)[None, :, None, :]
    x1, x2 = x[..., : dh // 2], x[..., dh // 2:]
    return jnp.concatenate([x1 * cos - x2 * sin, x1 * sin + x2 * cos], axis=-1)


def retention_chunkwise(q, k, v, log_rate):
    b, s, h, dh = q.shape
    n_chunks = s // CHUNK
    log_gamma = -jnp.exp(log_rate.astype(jnp.float32))
    j = jnp.arange(CHUNK, dtype=jnp.float32)
    diff = j[:, None] - j[None, :]
    d_intra = jnp.where(diff[None] >= 0,
                        jnp.exp(log_gamma[:, None, None] * jnp.maximum(diff, 0.0)[None]), 0.0)
    xi = jnp.exp(log_gamma[:, None] * (j + 1.0)[None])
    zeta = jnp.exp(log_gamma[:, None] * (CHUNK - 1.0 - j)[None])
    gamma_chunk = jnp.exp(log_gamma * CHUNK)

    def to_chunks(t):
        return t.reshape(b, n_chunks, CHUNK, h, dh).transpose(1, 0, 3, 2, 4)

    def step(state, inp):
        qc, kc, vc = inp
        scores = jnp.einsum('bhid,bhjd->bhij', qc, kc) * d_intra[None]
        inner = jnp.einsum('bhij,bhjd->bhid', scores, vc)
        cross = jnp.einsum('bhid,bhde->bhie', qc, state) * xi[None, :, :, None]
        new_state = state * gamma_chunk[None, :, None, None] + jnp.einsum(
            'bhjd,bhje->bhde', kc * zeta[None, :, :, None], vc)
        return new_state, inner + cross

    init = jnp.zeros((b, h, dh, dh), jnp.float32)
    _, out = lax.scan(step, init, (to_chunks(q), to_chunks(k), to_chunks(v)))
    return out.transpose(1, 0, 3, 2, 4).reshape(b, s, h, dh)


def mixer(x, w_in, rate_f, rate_b, gn_g, conv_w, w_out):
    b, s, _ = x.shape
    proj = x @ w_in
    r = RET_WIDTH
    c = CONV_WIDTH
    q, k, v, g, hc, bg, cg = jnp.split(
        proj, [r, 2 * r, 3 * r, 4 * r, 4 * r + c, 4 * r + 2 * c], axis=-1)
    shp = (b, s, RET_HEADS, RET_HEAD_DIM)
    qf = rotary(q.reshape(shp).astype(jnp.float32))
    kf = rotary(k.reshape(shp).astype(jnp.float32)) * (RET_HEAD_DIM ** -0.5)
    vf = v.reshape(shp).astype(jnp.float32)
    o_fwd = retention_chunkwise(qf, kf, vf, rate_f)
    o_bwd = jnp.flip(retention_chunkwise(jnp.flip(qf, 1), jnp.flip(kf, 1), jnp.flip(vf, 1), rate_b), 1)
    o = o_fwd + o_bwd
    mu = jnp.mean(o, axis=-1, keepdims=True)
    var = jnp.mean(jnp.square(o - mu), axis=-1, keepdims=True)
    o = ((o - mu) * lax.rsqrt(var + GN_EPS)).reshape(b, s, r) * gn_g.astype(jnp.float32)
    ret_out = (o * jax.nn.silu(g.astype(jnp.float32))).astype(x.dtype)
    u = cg * hc
    up = jnp.pad(u, ((0, 0), (1, 1), (0, 0)))
    conv = up[:, :-2] * conv_w[0] + up[:, 1:-1] * conv_w[1] + up[:, 2:] * conv_w[2]
    conv_out = bg * conv
    return jnp.concatenate([ret_out, conv_out], axis=-1) @ w_out


def peer(x, w_query, keys_1, keys_2, exp_u, exp_v):
    b, s, d = x.shape
    xb = x.reshape((b * s) // TOKEN_BLOCK, TOKEN_BLOCK, d)

    def block(xt):
        q = (xt @ w_query).reshape(TOKEN_BLOCK, PEER_HEADS, PEER_QUERY_DIM)
        q1, q2 = q[..., :PEER_HALF], q[..., PEER_HALF:]
        s1 = jnp.einsum('thd,hnd->thn', q1, keys_1)
        s2 = jnp.einsum('thd,hnd->thn', q2, keys_2)
        v1, i1 = lax.top_k(s1, PEER_TOPK)
        v2, i2 = lax.top_k(s2, PEER_TOPK)
        cand = (v1[..., :, None] + v2[..., None, :]).reshape(TOKEN_BLOCK, PEER_HEADS, PEER_TOPK * PEER_TOPK)
        cand_idx = (i1[..., :, None] * PEER_N_KEYS + i2[..., None, :]).reshape(
            TOKEN_BLOCK, PEER_HEADS, PEER_TOPK * PEER_TOPK)
        best, pos = lax.top_k(cand, PEER_TOPK)
        eid = jnp.take_along_axis(cand_idx, pos, axis=-1)
        gate = jax.nn.softmax(best.astype(jnp.float32), axis=-1).astype(xt.dtype)
        u_sel = exp_u[eid]
        act = jax.nn.gelu(jnp.einsum('thkd,td->thk', u_sel, xt), approximate=False)
        return jnp.einsum('thk,thkd->td', gate * act, exp_v[eid])

    return lax.map(block, xb).reshape(b, s, d)


def encoder_layer(x, w_in, rate_f, rate_b, gn_g, conv_w, w_out, ln1_g, ln1_b,
                  w_query, keys_1, keys_2, exp_u, exp_v, ln2_g, ln2_b):
    h = layer_norm(DEEPNORM_ALPHA * x + mixer(x, w_in, rate_f, rate_b, gn_g, conv_w, w_out), ln1_g, ln1_b)
    return layer_norm(DEEPNORM_ALPHA * h + peer(h, w_query, keys_1, keys_2, exp_u, exp_v), ln2_g, ln2_b)


def setup_inputs(seed: int = 0) -> dict:
    key = jax.random.key(seed)
    ks = jax.random.split(key, 20)
    f32 = jnp.float32
    base_rate = jnp.log(2.0 ** (-5.0 - jnp.arange(RET_HEADS, dtype=f32)))
    return {
        "x_prompt": jax.random.normal(ks[0], (BATCH, SEQ, D_MODEL), f32),
        "x_sample": jax.random.normal(ks[1], (DEC_BATCH, DEC_SEQ, D_MODEL), f32),
        "w_in": jax.random.normal(ks[2], (DEPTH, D_MODEL, IN_PROJ_WIDTH), f32) * D_MODEL ** -0.5,
        "ret_log_rate_fwd": base_rate[None] + 0.1 * jax.random.normal(ks[3], (DEPTH, RET_HEADS), f32),
        "ret_log_rate_bwd": base_rate[None] + 0.1 * jax.random.normal(ks[4], (DEPTH, RET_HEADS), f32),
        "ret_gn_g": 1.0 + 0.02 * jax.random.normal(ks[5], (DEPTH, RET_WIDTH), f32),
        "conv_w": jax.random.normal(ks[6], (DEPTH, CONV_K, CONV_WIDTH), f32) * CONV_K ** -0.5,
        "w_out": jax.random.normal(ks[7], (DEPTH, MIX_WIDTH, D_MODEL), f32) * (MIX_WIDTH ** -0.5) * DEEPNORM_BETA,
        "ln1_g": 1.0 + 0.02 * jax.random.normal(ks[8], (DEPTH, D_MODEL), f32),
        "ln1_b": 0.02 * jax.random.normal(ks[9], (DEPTH, D_MODEL), f32),
        "peer_w_query": jax.random.normal(ks[10], (DEPTH, D_MODEL, PEER_HEADS * PEER_QUERY_DIM), f32) * D_MODEL ** -0.5,
        "peer_keys_1": jax.random.normal(ks[11], (DEPTH, PEER_HEADS, PEER_N_KEYS, PEER_HALF), f32) * PEER_HALF ** -0.5,
        "peer_keys_2": jax.random.normal(ks[12], (DEPTH, PEER_HEADS, PEER_N_KEYS, PEER_HALF), f32) * PEER_HALF ** -0.5,
        "peer_u": jax.random.normal(ks[13], (DEPTH, PEER_N_EXPERTS, D_MODEL), f32) * D_MODEL ** -0.5,
        "peer_v": jax.random.normal(ks[14], (DEPTH, PEER_N_EXPERTS, D_MODEL), f32) * (PEER_HEADS ** -0.5) * DEEPNORM_BETA,
        "ln2_g": 1.0 + 0.02 * jax.random.normal(ks[15], (DEPTH, D_MODEL), f32),
        "ln2_b": 0.02 * jax.random.normal(ks[16], (DEPTH, D_MODEL), f32),
    }


def reference(x_prompt, x_sample, w_in, ret_log_rate_fwd, ret_log_rate_bwd, ret_gn_g, conv_w, w_out,
              ln1_g, ln1_b, peer_w_query, peer_keys_1, peer_keys_2, peer_u, peer_v, ln2_g, ln2_b):
    y_prompt = x_prompt
    y_sample = x_sample
    for l in range(DEPTH):
        params = (w_in[l], ret_log_rate_fwd[l], ret_log_rate_bwd[l], ret_gn_g[l], conv_w[l], w_out[l],
                  ln1_g[l], ln1_b[l], peer_w_query[l], peer_keys_1[l], peer_keys_2[l],
                  peer_u[l], peer_v[l], ln2_g[l], ln2_b[l])
        y_prompt = encoder_layer(y_prompt, *params)
        y_sample = encoder_layer(y_sample, *params)
    return (y_prompt, y_sample)
```

```cpp
#include <hip/hip_runtime.h>
#include <hip/hip_cooperative_groups.h>
#include <cstdio>
namespace cg = cooperative_groups;
namespace pg8 {
#define PG8_LAS __attribute__((address_space(3)))
typedef unsigned short bf16_t;
typedef short bf16x8 __attribute__((ext_vector_type(8)));
typedef float f32x4 __attribute__((ext_vector_type(4)));
typedef unsigned u32x4 __attribute__((ext_vector_type(4)));
constexpr int BM = 256, BK = 64, HALF = 128, HTB = HALF * BK * 2  , STAGE_BYTES = 8 * HTB, NXCD = 8, WGM = 8;

__host__ __device__ __forceinline__ int lds_byte(int r, int c) { const int st = (r >> 4) * 2 + (c >> 5), rr = r & 15, cc = c & 31, ob = rr * 64 + cc * 2; return st * 1024 + (ob ^ (((ob >> 9) & 1) << 5)); }
__host__ __device__ __forceinline__ void stage_rc(int b, int& R, int& C) { const int st = b / 1024, sb = b % 1024, swz = sb ^ (((sb >> 9) & 1) << 5); R = (st >> 1) * 16 + swz / 64; C = (st & 1) * 32 + (swz % 64) / 2; }
__host__ __device__ __forceinline__ int perm32(int rho) { const int n = rho >> 4, i = rho & 15; return 8 * (i >> 2) + 4 * n + (i & 3); }

struct Unit { int pm, pn; };
struct Gemm { const bf16_t* A; const bf16_t* Bt; int M, N, K; };

struct StaticOrder {
    int nM, nN, nwg, G, c;
    __host__ __device__ void init(int M, int N, int G_, int c_) { nM = M / BM; nN = N / BM; nwg = nM * nN; G = G_; c = c_; }
    __host__ __device__ bool next(int i, Unit& u) const {
        const long L = (long)i * G + c; if (L >= nwg) return false;
        int wgid = (int)L; { const int q = nwg / NXCD, r = nwg % NXCD, xcd = wgid % NXCD, off = wgid / NXCD; wgid = (xcd < r ? xcd * (q + 1) : r * (q + 1) + (xcd - r) * q) + off; }
        const int nig = WGM * nN, gid = wgid / nig, fm = gid * WGM, gsz = (nM - fm) < WGM ? (nM - fm) : WGM;
        u.pm = fm + ((wgid % nig) % gsz); u.pn = (wgid % nig) / gsz; return true;
    }
    __device__ __forceinline__ void a_ready(const Unit&) const {}
    __device__ __forceinline__ void done(const Unit&) const {}
};
template <class Epi, class Sched, bool STAMP = false>
__device__ __forceinline__ void gemm_phase(PG8_LAS unsigned char* lds, const Gemm g, const Sched& S, const Epi& E, unsigned long long* stamps) {
    const int tid = threadIdx.x, wid = __builtin_amdgcn_readfirstlane(tid >> 6), lane = tid & 63, wr = wid >> 2, wc = wid & 3, fr = lane & 15, fq = lane >> 4;
    const int K = g.K, nt = K / BK;
    int ts_lo = 0, ts_hi = 0, nts = 0; const unsigned long long rt_entry = STAMP ? (unsigned long long)wall_clock64() : 0ull;
#define PG8_STAMP() do { if (STAMP && wid == 0 && nts < 64) { const unsigned long long _c = (unsigned long long)clock64(); \
        ts_lo = (lane == nts) ? (int)(unsigned)_c : ts_lo; ts_hi = (lane == nts) ? (int)(unsigned)(_c >> 32) : ts_hi; ++nts; } } while (0)
    PG8_STAMP();
    unsigned voffA[2], voffB[2];
#pragma unroll
    for (int i = 0; i < 2; ++i) { int R, C; stage_rc(tid * 16 + i * 8192, R, C); const int Rb = Epi::PERM ? ((R & ~31) + perm32(R & 31)) : R;
        voffA[i] = (unsigned)(R * K + C) * 2u; voffB[i] = (unsigned)(Rb * K + C) * 2u; }
    const size_t kstep = (size_t)(BK * 2);
    const size_t hstep = (size_t)HALF * K * 2;
    const size_t tstep = 2 * hstep;
    const unsigned ldsw = (unsigned)wid * 1024u;
    const int aoff = lds_byte(wr * 64 + fr, fq * 8), boff = lds_byte(wc * 32 + fr, fq * 8);
#define PG8_SA(b, h) (((b) * 2 + (h)) * HTB)
#define PG8_SB(b, h) ((4 + (b) * 2 + (h)) * HTB)
#define PG8_STAGE(bufoff, gbase, voff) do { _Pragma("unroll") for (int _i = 0; _i < 2; ++_i) \
        __builtin_amdgcn_global_load_lds((const unsigned*)((const char*)(gbase) + (voff)[_i]), (PG8_LAS unsigned*)(lds + (bufoff) + ldsw + _i * 8192), 16, 0, 0); } while (0)
#define PG8_LDA(dst, b, h) do { _Pragma("unroll") for (int m = 0; m < 4; ++m) _Pragma("unroll") for (int k = 0; k < 2; ++k) dst[m][k] = *(const PG8_LAS bf16x8*)(lds + PG8_SA(b, h) + aoff + m * 2048 + k * 1024); } while (0)
#define PG8_LDB(dst, b, h) do { _Pragma("unroll") for (int n = 0; n < 2; ++n) _Pragma("unroll") for (int k = 0; k < 2; ++k) dst[n][k] = *(const PG8_LAS bf16x8*)(lds + PG8_SB(b, h) + boff + n * 2048 + k * 1024); } while (0)
#define PG8_MMA(ai, bj, At, Bt) do { __builtin_amdgcn_s_setprio(1); _Pragma("unroll") for (int m = 0; m < 4; ++m) _Pragma("unroll") for (int n = 0; n < 2; ++n) _Pragma("unroll") for (int k = 0; k < 2; ++k) \
        acc[ai][bj][m][n] = __builtin_amdgcn_mfma_f32_16x16x32_bf16(Bt[n][k], At[m][k], acc[ai][bj][m][n], 0, 0, 0); __builtin_amdgcn_s_setprio(0); } while (0)
#define PG8_WAIT_V(n) asm volatile("s_waitcnt vmcnt(" #n ")" ::: "memory")
#define PG8_WAIT_L(n) asm volatile("s_waitcnt lgkmcnt(" #n ")" ::: "memory")
#define PG8_BAR __builtin_amdgcn_s_barrier()
#define PG8_SCHED __builtin_amdgcn_sched_barrier(0)
    Unit cur, nxt; int ui = 0;
    if (!S.next(0, cur)) return;
    f32x4 acc[2][2][4][2];
#pragma unroll
    for (int a = 0; a < 2; ++a)
#pragma unroll
        for (int b = 0; b < 2; ++b)
#pragma unroll
            for (int m = 0; m < 4; ++m)
#pragma unroll
                for (int n = 0; n < 2; ++n) acc[a][b][m][n] = (f32x4){0.f, 0.f, 0.f, 0.f};
    bf16x8 At[4][2], B0[2][2], B1[2][2];
    const char* cA = (const char*)g.A + (size_t)cur.pm * tstep; const char* cB = (const char*)g.Bt + (size_t)cur.pn * tstep;
    S.a_ready(cur);
    PG8_STAGE(PG8_SB(0, 0), cB, voffB); PG8_STAGE(PG8_SA(0, 0), cA, voffA); PG8_STAGE(PG8_SB(0, 1), cB + hstep, voffB); PG8_STAGE(PG8_SA(0, 1), cA + hstep, voffA);
    if (wr == 1) PG8_BAR;
    PG8_WAIT_V(4); PG8_BAR;
    PG8_STAGE(PG8_SB(1, 0), cB + kstep, voffB); PG8_STAGE(PG8_SA(1, 0), cA + kstep, voffA); PG8_STAGE(PG8_SB(1, 1), cB + hstep + kstep, voffB);
    PG8_WAIT_V(6); PG8_BAR;
    PG8_STAMP();
    for (;;) {
        const bool has_next = S.next(ui + 1, nxt);
        const char* nA = has_next ? (const char*)g.A + (size_t)nxt.pm * tstep : cA; const char* nB = has_next ? (const char*)g.Bt + (size_t)nxt.pn * tstep : cB;
        for (int t = 0; t < nt; t += 2) {
            const bool last = (t == nt - 2);
            const char* a1 = cA + (size_t)(t + 1) * kstep;
            const char* a2 = last ? nA : cA + (size_t)(t + 2) * kstep; const char* b2 = last ? nB : cB + (size_t)(t + 2) * kstep;
            const char* a3 = a2 + kstep; const char* b3 = b2 + kstep;
            if (last && has_next) S.a_ready(nxt);
            PG8_LDB(B0, 0, 0); PG8_SCHED; PG8_LDA(At, 0, 0); PG8_STAGE(PG8_SA(1, 1), a1 + hstep, voffA);
            PG8_WAIT_L(8); PG8_BAR; PG8_WAIT_L(0); PG8_MMA(0, 0, At, B0); PG8_BAR; PG8_SCHED;
            PG8_LDB(B1, 0, 1); PG8_STAGE(PG8_SB(0, 0), b2, voffB);
            PG8_BAR; PG8_WAIT_L(0); PG8_MMA(0, 1, At, B1); PG8_BAR;
            PG8_LDA(At, 0, 1); PG8_STAGE(PG8_SA(0, 0), a2, voffA);
            PG8_BAR; PG8_WAIT_L(0); PG8_MMA(1, 0, At, B0); PG8_BAR; PG8_SCHED;
            PG8_STAGE(PG8_SB(0, 1), b2 + hstep, voffB);
            PG8_WAIT_V(6); PG8_BAR; PG8_MMA(1, 1, At, B1); PG8_BAR;
            PG8_LDB(B0, 1, 0); PG8_SCHED; PG8_LDA(At, 1, 0); PG8_STAGE(PG8_SA(0, 1), a2 + hstep, voffA);
            PG8_WAIT_L(8); PG8_BAR; PG8_WAIT_L(0); PG8_MMA(0, 0, At, B0); PG8_BAR; PG8_SCHED;
            PG8_LDB(B1, 1, 1); PG8_STAGE(PG8_SB(1, 0), b3, voffB);
            PG8_BAR; PG8_WAIT_L(0); PG8_MMA(0, 1, At, B1); PG8_BAR;
            PG8_LDA(At, 1, 1); PG8_STAGE(PG8_SA(1, 0), a3, voffA);
            PG8_BAR; PG8_WAIT_L(0); PG8_MMA(1, 0, At, B0); PG8_BAR; PG8_SCHED;
            PG8_STAGE(PG8_SB(1, 1), b3 + hstep, voffB);
            PG8_WAIT_V(6); PG8_BAR; PG8_MMA(1, 1, At, B1); PG8_BAR;
        }
        PG8_STAMP();
        if constexpr (!Epi::AFTER_DRAIN) { E(acc, cur, wr, wc, fr, fq); S.done(cur); }
        PG8_STAMP();
        if (!has_next) break;
#pragma unroll
        for (int a = 0; a < 2; ++a)
#pragma unroll
            for (int b = 0; b < 2; ++b)
#pragma unroll
                for (int m = 0; m < 4; ++m)
#pragma unroll
                    for (int n = 0; n < 2; ++n) acc[a][b][m][n] = (f32x4){0.f, 0.f, 0.f, 0.f};
        cur = nxt; cA = nA; cB = nB; ++ui;
    }
    PG8_WAIT_V(0);
    if (wr == 0) PG8_BAR;
    PG8_BAR;
    if constexpr (Epi::AFTER_DRAIN) { E.fused(acc, cur, wr, wc, fr, fq, lds, wid, lane); S.done(cur); }
    PG8_STAMP();
    if (STAMP && wid == 0) { stamps[lane] = lane < nts ? (((unsigned long long)(unsigned)ts_hi << 32) | (unsigned)ts_lo) : 0ull;
        if (lane == 62) stamps[62] = rt_entry; if (lane == 63) stamps[63] = (unsigned long long)wall_clock64(); }
#undef PG8_STAMP
#undef PG8_SA
#undef PG8_SB
#undef PG8_STAGE
#undef PG8_LDA
#undef PG8_LDB
#undef PG8_MMA
#undef PG8_WAIT_V
#undef PG8_WAIT_L
#undef PG8_BAR
#undef PG8_SCHED
}
}

using pg8::bf16_t; using pg8::bf16x8; using pg8::f32x4; using pg8::u32x4;
typedef unsigned u32x2 __attribute__((ext_vector_type(2)));
typedef __bf16 bf16x2_t __attribute__((ext_vector_type(2)));
typedef float f32x2_t __attribute__((ext_vector_type(2)));
#define DI __device__ __forceinline__

constexpr int TOK = 24576, DM = 2048, NPROJ = 7168, RW = 1024;
constexpr float ALPHA = 1.189207115002721f;
constexpr float LOG2E = 1.4426950408889634f;
constexpr size_t MiB = 1048576;
constexpr size_t WS_R0 = 0;
constexpr size_t WS_R1 = 128 * MiB;
constexpr size_t WS_R2 = 224 * MiB;
constexpr size_t WS_R3 = 320 * MiB;
constexpr size_t WS_W  = 416 * MiB;
constexpr size_t WS_END = 460 * MiB;

struct Params {
    const float *x_prompt, *x_sample, *w_in, *rate_f, *rate_b, *gn_g, *conv_w, *w_out, *ln1_g, *ln1_b, *w_query, *keys1, *keys2, *peer_u, *peer_v, *ln2_g, *ln2_b;
    float* out; unsigned char* ws;
};

DI unsigned pk2(float a, float b) { f32x2_t v = {a, b}; return __builtin_bit_cast(unsigned, __builtin_convertvector(v, bf16x2_t)); }
DI float bf_lo(unsigned w) { return __uint_as_float(w << 16); }
DI float bf_hi(unsigned w) { return __uint_as_float(w & 0xffff0000u); }
DI f32x4 mfma16(bf16x8 a, bf16x8 b, f32x4 c) { return __builtin_amdgcn_mfma_f32_16x16x32_bf16(a, b, c, 0, 0, 0); }
DI float wave_sum(float x) { x += __shfl_xor(x, 1); x += __shfl_xor(x, 2); x += __shfl_xor(x, 4); x += __shfl_xor(x, 8); x += __shfl_xor(x, 16); x += __shfl_xor(x, 32); return x; }
DI float dot2bf(unsigned a, unsigned b, float c) { return __builtin_amdgcn_fdot2_f32_bf16(__builtin_bit_cast(bf16x2_t, a), __builtin_bit_cast(bf16x2_t, b), c, false); }
DI const float* xrow(const Params& p, int tok) { return tok < 8192 ? p.x_prompt + (size_t)tok * DM : p.x_sample + (size_t)(tok - 8192) * DM; }

DI int map_inproj(int c) {
    if (c < 2048) { const int blk = c >> 7, cc = c & 127, g = cc >> 3, j = cc & 7; return blk * 128 + 4 * g + (j & 3) + 64 * (j >> 2); }
    if (c < 4096) return c;
    if (c < 6144) { const int t = (c - 4096) >> 8, wi = (c - 4096) & 255, half = wi >> 7, col = wi & 127; return (half ? 6144 : 4096) + 128 * t + col; }
    return 5120 + (c - 6144);
}
template <bool MAPPED> DI void transpose_convert(const float* __restrict__ src, int ld, bf16_t* __restrict__ dst, int N, int bid, int nb) {
    const int lane = threadIdx.x & 63, w = threadIdx.x >> 6, nch = N / 64;
    for (int it = bid; it < nch * 32; it += nb) {
        const int chi = it % nch, k8hi = it / nch, c = chi * 64 + lane, k8 = k8hi * 8 + w;
        const int sc = MAPPED ? map_inproj(c) : c;
        const float* s = src + (size_t)(k8 * 8) * ld + sc;
        float v[8];
#pragma unroll
        for (int i = 0; i < 8; ++i) v[i] = s[(size_t)i * ld];
        u32x4 o; o.x = pk2(v[0], v[1]); o.y = pk2(v[2], v[3]); o.z = pk2(v[4], v[5]); o.w = pk2(v[6], v[7]);
        *(u32x4*)(dst + (size_t)c * 2048 + k8 * 8) = o;
    }
}
DI void convert_flat(const float* __restrict__ src, bf16_t* __restrict__ dst, size_t n8, int bid, int nb) {
    for (size_t i = (size_t)bid * 512 + threadIdx.x; i < n8; i += (size_t)nb * 512) {
        const float4 a = *(const float4*)(src + i * 8), b = *(const float4*)(src + i * 8 + 4);
        u32x4 o; o.x = pk2(a.x, a.y); o.y = pk2(a.z, a.w); o.z = pk2(b.x, b.y); o.w = pk2(b.z, b.w);
        *(u32x4*)(dst + i * 8) = o;
    }
}
DI void fold_phase(const float* __restrict__ wq, const float* __restrict__ k1, const float* __restrict__ k2, bf16_t* __restrict__ WqkT, unsigned char* lds, int bid, int nb) {
    float* sK = (float*)lds; float* sW = sK + 128 * 132;
    const int tid = threadIdx.x;
    for (int it = bid; it < 512; it += nb) {
        const int hh = it >> 5, kt = it & 31, head = hh >> 1, half = hh & 1;
        const float* keys = (half ? k2 : k1) + (size_t)head * 16384;
        __syncthreads();
        for (int p = tid; p < 4096; p += 512) { const int n = p >> 5, d4 = p & 31; *(float4*)(sK + n * 132 + d4 * 4) = *(const float4*)(keys + n * 128 + d4 * 4); }
        for (int p = tid; p < 2048; p += 512) { const int kk = p >> 5, d4 = p & 31; *(float4*)(sW + kk * 132 + d4 * 4) = *(const float4*)(wq + (size_t)(kt * 64 + kk) * 2048 + hh * 128 + d4 * 4); }
        __syncthreads();
        const int n = tid & 127, kq = tid >> 7;
        float acc[16];
#pragma unroll
        for (int i = 0; i < 16; ++i) acc[i] = 0.f;
        for (int d4 = 0; d4 < 32; ++d4) {
            const float4 kv = *(const float4*)(sK + n * 132 + d4 * 4);
#pragma unroll
            for (int i = 0; i < 16; ++i) { const float4 wv = *(const float4*)(sW + (kq * 16 + i) * 132 + d4 * 4); acc[i] += kv.x * wv.x + kv.y * wv.y + kv.z * wv.z + kv.w * wv.w; }
        }
        bf16_t* dst = WqkT + (size_t)(hh * 128 + n) * 2048 + kt * 64 + kq * 16;
        u32x4 o0, o1; o0.x = pk2(acc[0], acc[1]); o0.y = pk2(acc[2], acc[3]); o0.z = pk2(acc[4], acc[5]); o0.w = pk2(acc[6], acc[7]);
        o1.x = pk2(acc[8], acc[9]); o1.y = pk2(acc[10], acc[11]); o1.z = pk2(acc[12], acc[13]); o1.w = pk2(acc[14], acc[15]);
        *(u32x4*)dst = o0; *(u32x4*)(dst + 8) = o1;
    }
}

struct EpiInProj {
    static constexpr bool PERM = true, AFTER_DRAIN = false;
    bf16_t *Q, *U, *BG;
    __device__ __forceinline__ void operator()(const f32x4 (&acc)[2][2][4][2], const pg8::Unit& u, int wr, int wc, int fr, int fq) const {
        const int pn = u.pn, row0 = u.pm * 256 + wr * 64 + fr, cl = wc * 32 + 8 * fq;
        if (pn < 8) {
            bf16_t* dst = Q + (size_t)(pn >> 2) * ((size_t)TOK * RW); const float sc = pn < 4 ? 1.0f : 0.08838834764831845f; const int colbase = (pn & 3) * 256 + cl;
            float cf[4];
#pragma unroll
            for (int e = 0; e < 4; ++e) cf[e] = exp2f(-(float)(cl / 2 + e) * 0.20762050593046014f) * 0.15915494309189535f;
#pragma unroll
            for (int ai = 0; ai < 2; ++ai)
#pragma unroll
                for (int m = 0; m < 4; ++m) {
                    const int row = row0 + ai * 128 + m * 16; const float pos = (float)(row & 8191);
                    float cs[4], sn[4];
#pragma unroll
                    for (int e = 0; e < 4; ++e) { const float pp = pos * cf[e], er = fmaf(pos, cf[e], -pp), frv = (pp - floorf(pp)) + er; sn[e] = __builtin_amdgcn_sinf(frv); cs[e] = __builtin_amdgcn_cosf(frv); }
#pragma unroll
                    for (int bj = 0; bj < 2; ++bj) {
                        const f32x4 x1 = acc[ai][bj][m][0], x2 = acc[ai][bj][m][1]; float o1[4], o2[4];
#pragma unroll
                        for (int e = 0; e < 4; ++e) { o1[e] = (x1[e] * cs[e] - x2[e] * sn[e]) * sc; o2[e] = (x1[e] * sn[e] + x2[e] * cs[e]) * sc; }
                        u32x4 w; w.x = pk2(o1[0], o1[1]); w.y = pk2(o1[2], o1[3]); w.z = pk2(o2[0], o2[1]); w.w = pk2(o2[2], o2[3]);
                        *(u32x4*)(dst + (size_t)row * RW + colbase + bj * 128) = w;
                    }
                }
        } else if (pn < 16 || pn >= 24) {
            bf16_t* dst = pn < 16 ? Q + (size_t)(pn >> 2) * ((size_t)TOK * RW) : BG; const int colbase = (pn & 3) * 256 + cl;
#pragma unroll
            for (int ai = 0; ai < 2; ++ai)
#pragma unroll
                for (int m = 0; m < 4; ++m) {
                    const int row = row0 + ai * 128 + m * 16;
#pragma unroll
                    for (int bj = 0; bj < 2; ++bj) {
                        const f32x4 v0 = acc[ai][bj][m][0], v1 = acc[ai][bj][m][1];
                        u32x4 w; w.x = pk2(v0[0], v0[1]); w.y = pk2(v0[2], v0[3]); w.z = pk2(v1[0], v1[1]); w.w = pk2(v1[2], v1[3]);
                        *(u32x4*)(dst + (size_t)row * RW + colbase + bj * 128) = w;
                    }
                }
        } else {
            const int colbase = (pn - 16) * 128 + cl;
#pragma unroll
            for (int ai = 0; ai < 2; ++ai)
#pragma unroll
                for (int m = 0; m < 4; ++m) {
                    const int row = row0 + ai * 128 + m * 16;
                    const f32x4 v0 = acc[ai][0][m][0] * acc[ai][1][m][0], v1 = acc[ai][0][m][1] * acc[ai][1][m][1];
                    u32x4 w; w.x = pk2(v0[0], v0[1]); w.y = pk2(v0[2], v0[3]); w.z = pk2(v1[0], v1[1]); w.w = pk2(v1[2], v1[3]);
                    *(u32x4*)(U + (size_t)row * RW + colbase) = w;
                }
        }
    }
};
struct EpiOutProj {
    static constexpr bool PERM = true, AFTER_DRAIN = false;
    const float *xp, *xs; bf16_t* Z;
    __device__ __forceinline__ void operator()(const f32x4 (&acc)[2][2][4][2], const pg8::Unit& u, int wr, int wc, int fr, int fq) const {
        const int row0 = u.pm * 256 + wr * 64 + fr, col0 = u.pn * 256 + wc * 32 + 8 * fq;
        const float* xb = u.pm < 32 ? xp : xs - (size_t)8192 * DM;
#pragma unroll
        for (int ai = 0; ai < 2; ++ai)
#pragma unroll
            for (int m = 0; m < 4; ++m) {
                const int row = row0 + ai * 128 + m * 16;
#pragma unroll
                for (int bj = 0; bj < 2; ++bj) {
                    const float* xr = xb + (size_t)row * DM + col0 + bj * 128;
                    const f32x4 a = *(const f32x4*)xr, b = *(const f32x4*)(xr + 4);
                    const f32x4 v0 = acc[ai][bj][m][0] + ALPHA * a, v1 = acc[ai][bj][m][1] + ALPHA * b;
                    u32x4 w; w.x = pk2(v0[0], v0[1]); w.y = pk2(v0[2], v0[3]); w.z = pk2(v1[0], v1[1]); w.w = pk2(v1[2], v1[3]);
                    *(u32x4*)(Z + (size_t)row * DM + col0 + bj * 128) = w;
                }
            }
    }
};
struct EpiScore {
    static constexpr bool PERM = false, AFTER_DRAIN = false;
    float* C;
    __device__ __forceinline__ void operator()(const f32x4 (&acc)[2][2][4][2], const pg8::Unit& u, int wr, int wc, int fr, int fq) const {
        const int row0 = u.pm * 256 + wr * 64 + fr, col0 = u.pn * 256 + wc * 32 + 4 * fq;
#pragma unroll
        for (int ai = 0; ai < 2; ++ai)
#pragma unroll
            for (int m = 0; m < 4; ++m) { float* rowp = C + (size_t)(row0 + ai * 128 + m * 16) * DM + col0;
#pragma unroll
                for (int bj = 0; bj < 2; ++bj)
#pragma unroll
                    for (int n = 0; n < 2; ++n) *(f32x4*)(rowp + bj * 128 + n * 16) = acc[ai][bj][m][n]; }
    }
};

DI unsigned tile_off(int r, int j) { return (unsigned)(r * 256 + ((((j >> 3) ^ (r & 15))) << 4) + (j & 7) * 2); }
template <int E> DI unsigned short bfel(const u32x4& v) { const unsigned w = v[E >> 1]; return (unsigned short)((E & 1) ? (w >> 16) : (w & 0xffffu)); }
template <int E> DI float bfelf(const u32x4& v) { const unsigned w = v[E >> 1]; return (E & 1) ? bf_hi(w) : bf_lo(w); }

DI void r1_phase(const bf16_t* __restrict__ K, const bf16_t* __restrict__ V, bf16_t* __restrict__ KVf, bf16_t* __restrict__ KVb, const float* rate_f, const float* rate_b,
                 unsigned char* lds, int bid, int nb) {
    const int tid = threadIdx.x, lane = tid & 63, w = tid >> 6, m16 = lane & 15, quad = lane >> 4;
    unsigned char* sKf = lds; unsigned char* sKb = lds + 32768; unsigned char* sV = lds + 65536;
    for (int item = bid; item < 1536; item += nb) {
        const int hd = item & 7; const size_t T0 = (size_t)(item >> 3) * 128;
        const float lgf = -__expf(rate_f[hd]) * LOG2E, lgb = -__expf(rate_b[hd]) * LOG2E;
        __syncthreads();
#pragma unroll
        for (int i = 0; i < 2; ++i) {
            const int p = tid + 512 * i, j = (p >> 4) * 2, d8 = p & 15;
            const bf16_t* kp = K + (T0 + j) * RW + hd * 128 + d8 * 8; const bf16_t* vp = V + (T0 + j) * RW + hd * 128 + d8 * 8;
            const u32x4 k0 = *(const u32x4*)kp, k1 = *(const u32x4*)(kp + RW), v0 = *(const u32x4*)vp, v1 = *(const u32x4*)(vp + RW);
            const float zf0 = exp2f(lgf * (float)(127 - j)), zf1 = exp2f(lgf * (float)(126 - j)), zb0 = exp2f(lgb * (float)j), zb1 = exp2f(lgb * (float)(j + 1));
#define R1_EL(E) { const int d = d8 * 8 + E; const unsigned off = tile_off(d, j); const float ka = bfelf<E>(k0), kb = bfelf<E>(k1); \
                *(unsigned*)(sKf + off) = pk2(ka * zf0, kb * zf1); *(unsigned*)(sKb + off) = pk2(ka * zb0, kb * zb1); \
                *(unsigned*)(sV + off) = (unsigned)bfel<E>(v0) | ((unsigned)bfel<E>(v1) << 16); }
            R1_EL(0) R1_EL(1) R1_EL(2) R1_EL(3) R1_EL(4) R1_EL(5) R1_EL(6) R1_EL(7)
#undef R1_EL
        }
        __syncthreads();
        f32x4 af[8], ab[8];
#pragma unroll
        for (int mt = 0; mt < 8; ++mt) { af[mt] = (f32x4){0.f, 0.f, 0.f, 0.f}; ab[mt] = (f32x4){0.f, 0.f, 0.f, 0.f}; }
#pragma unroll
        for (int ks = 0; ks < 4; ++ks) {
            const int vr = 16 * w + m16;
            const bf16x8 bv = *(const bf16x8*)(sV + vr * 256 + ((((4 * ks + quad) ^ (vr & 15))) << 4));
#pragma unroll
            for (int mt = 0; mt < 8; ++mt) {
                const int r = 16 * mt + m16; const unsigned o = r * 256 + ((((4 * ks + quad) ^ (r & 15))) << 4);
                const bf16x8 a_f = *(const bf16x8*)(sKf + o), a_b = *(const bf16x8*)(sKb + o);
                af[mt] = mfma16(a_f, bv, af[mt]); ab[mt] = mfma16(a_b, bv, ab[mt]);
            }
        }
        const size_t ob = (size_t)item * 16384 + (size_t)(16 * w + m16) * 128 + 4 * quad;
#pragma unroll
        for (int mt = 0; mt < 8; ++mt) {
            u32x2 a; a.x = pk2(af[mt][0], af[mt][1]); a.y = pk2(af[mt][2], af[mt][3]); *(u32x2*)(KVf + ob + 16 * mt) = a;
            u32x2 b; b.x = pk2(ab[mt][0], ab[mt][1]); b.y = pk2(ab[mt][2], ab[mt][3]); *(u32x2*)(KVb + ob + 16 * mt) = b;
        }
    }
}

DI void r2_phase(const bf16_t* __restrict__ KVf, const bf16_t* __restrict__ KVb, bf16_t* __restrict__ Sf, bf16_t* __restrict__ Sb, const float* rate_f, const float* rate_b, int bid, int nb) {
    for (int g = bid * 512 + threadIdx.x; g < 98304; g += nb * 512) {
        const int dir = g / 49152, rem = g % 49152, sh = rem >> 11, piece = rem & 2047, s = sh >> 3, hd = sh & 7;
        const float lg = -__expf((dir ? rate_b : rate_f)[hd]) * LOG2E, Gc = exp2f(lg * 128.f);
        const bf16_t* src = dir ? KVb : KVf; bf16_t* dst = dir ? Sb : Sf;
        float st[8];
#pragma unroll
        for (int e = 0; e < 8; ++e) st[e] = 0.f;
        for (int cc = 0; cc < 64; ++cc) {
            const int c = dir ? 63 - cc : cc;
            const size_t off = ((size_t)((s * 64 + c) * 8 + hd)) * 16384 + (size_t)piece * 8;
            const u32x4 kv = *(const u32x4*)(src + off);
            u32x4 o; o.x = pk2(st[0], st[1]); o.y = pk2(st[2], st[3]); o.z = pk2(st[4], st[5]); o.w = pk2(st[6], st[7]);
            *(u32x4*)(dst + off) = o;
            st[0] = st[0] * Gc + bf_lo(kv.x); st[1] = st[1] * Gc + bf_hi(kv.x); st[2] = st[2] * Gc + bf_lo(kv.y); st[3] = st[3] * Gc + bf_hi(kv.y);
            st[4] = st[4] * Gc + bf_lo(kv.z); st[5] = st[5] * Gc + bf_hi(kv.z); st[6] = st[6] * Gc + bf_lo(kv.w); st[7] = st[7] * Gc + bf_hi(kv.w);
        }
    }
}

DI float silu_f(float x) { return x / (1.0f + __expf(-x)); }

DI void r3_phase(const bf16_t* __restrict__ Q, const bf16_t* __restrict__ K, const bf16_t* __restrict__ V, const bf16_t* __restrict__ G, const bf16_t* __restrict__ Sf, const bf16_t* __restrict__ Sb,
                 const float* rate_f, const float* rate_b, const float* __restrict__ gn_g, bf16_t* __restrict__ mix, unsigned char* lds, int bid, int nb) {
    const int tid = threadIdx.x, lane = tid & 63, w = tid >> 6, m16 = lane & 15, quad = lane >> 4;
    unsigned char* sV = lds;
    for (int item = bid; item < 1536; item += nb) {
        const int hd = item & 7; const size_t T0 = (size_t)(item >> 3) * 128;
        const float lgf = -__expf(rate_f[hd]) * LOG2E, lgb = -__expf(rate_b[hd]) * LOG2E;
        __syncthreads();
#pragma unroll
        for (int i = 0; i < 2; ++i) {
            const int p = tid + 512 * i, j = (p >> 4) * 2, d8 = p & 15;
            const bf16_t* vp = V + (T0 + j) * RW + hd * 128 + d8 * 8;
            const u32x4 v0 = *(const u32x4*)vp, v1 = *(const u32x4*)(vp + RW);
#define R3_EL(E) { *(unsigned*)(sV + tile_off(d8 * 8 + E, j)) = (unsigned)bfel<E>(v0) | ((unsigned)bfel<E>(v1) << 16); }
            R3_EL(0) R3_EL(1) R3_EL(2) R3_EL(3) R3_EL(4) R3_EL(5) R3_EL(6) R3_EL(7)
#undef R3_EL
        }
        __syncthreads();
        const int il = 16 * w + m16;
        const size_t tq = T0 + il;
        bf16x8 bq[4];
#pragma unroll
        for (int ks = 0; ks < 4; ++ks) bq[ks] = *(const bf16x8*)(Q + tq * RW + hd * 128 + 32 * ks + 8 * quad);
        f32x4 aS[8];
#pragma unroll
        for (int mt = 0; mt < 8; ++mt) aS[mt] = (f32x4){0.f, 0.f, 0.f, 0.f};
#pragma unroll
        for (int ks = 0; ks < 4; ++ks)
#pragma unroll
            for (int mt = 0; mt < 8; ++mt) {
                const bf16x8 ak = *(const bf16x8*)(K + (T0 + 16 * mt + m16) * RW + hd * 128 + 32 * ks + 8 * quad);
                aS[mt] = mfma16(ak, bq[ks], aS[mt]);
            }
        bf16x8 bp[4];
#pragma unroll
        for (int s = 0; s < 4; ++s) {
            float pv[8];
#pragma unroll
            for (int t = 0; t < 8; ++t) {
                const int mt = 2 * s + (t >> 2), r = t & 3, j = 16 * mt + 4 * quad + r, dl = il - j;
                const float dec = dl > 0 ? exp2f(lgf * (float)dl) : (dl < 0 ? exp2f(lgb * (float)(-dl)) : 2.0f);
                pv[t] = aS[mt][r] * dec;
            }
            u32x4 pk; pk.x = pk2(pv[0], pv[1]); pk.y = pk2(pv[2], pv[3]); pk.z = pk2(pv[4], pv[5]); pk.w = pk2(pv[6], pv[7]);
            bp[s] = __builtin_bit_cast(bf16x8, pk);
        }
        f32x4 aO[8];
#pragma unroll
        for (int mt = 0; mt < 8; ++mt) aO[mt] = (f32x4){0.f, 0.f, 0.f, 0.f};
#pragma unroll
        for (int s = 0; s < 4; ++s)
#pragma unroll
            for (int mt = 0; mt < 8; ++mt) {
                const int row = 16 * mt + m16;
                const u32x2 lo = *(const u32x2*)(sV + row * 256 + ((((4 * s + (quad >> 1)) ^ (row & 15))) << 4) + (quad & 1) * 8);
                const u32x2 hi = *(const u32x2*)(sV + row * 256 + ((((4 * s + 2 + (quad >> 1)) ^ (row & 15))) << 4) + (quad & 1) * 8);
                u32x4 av; av.x = lo.x; av.y = lo.y; av.z = hi.x; av.w = hi.y;
                aO[mt] = mfma16(__builtin_bit_cast(bf16x8, av), bp[s], aO[mt]);
            }
#pragma unroll
        for (int dir = 0; dir < 2; ++dir) {
            const bf16_t* S = (dir ? Sb : Sf) + (size_t)item * 16384;
            f32x4 aX[8];
#pragma unroll
            for (int mt = 0; mt < 8; ++mt) aX[mt] = (f32x4){0.f, 0.f, 0.f, 0.f};
#pragma unroll
            for (int ks = 0; ks < 4; ++ks)
#pragma unroll
                for (int mt = 0; mt < 8; ++mt) {
                    const bf16x8 a = *(const bf16x8*)(S + (16 * mt + m16) * 128 + 32 * ks + 8 * quad);
                    aX[mt] = mfma16(a, bq[ks], aX[mt]);
                }
            const float xi = dir ? exp2f(lgb * (float)(128 - il)) : exp2f(lgf * (float)(il + 1));
#pragma unroll
            for (int mt = 0; mt < 8; ++mt) aO[mt] += xi * aX[mt];
        }
        float sum = 0.f;
#pragma unroll
        for (int mt = 0; mt < 8; ++mt) sum += (aO[mt][0] + aO[mt][1]) + (aO[mt][2] + aO[mt][3]);
        sum += __shfl_xor(sum, 16); sum += __shfl_xor(sum, 32);
        const float mu = sum * (1.0f / 128.0f); float qv = 0.f;
#pragma unroll
        for (int mt = 0; mt < 8; ++mt) { const f32x4 d = aO[mt] - mu; qv += (d[0] * d[0] + d[1] * d[1]) + (d[2] * d[2] + d[3] * d[3]); }
        qv += __shfl_xor(qv, 16); qv += __shfl_xor(qv, 32);
        const float rstd = rsqrtf(qv * (1.0f / 128.0f) + 1e-6f);
#pragma unroll
        for (int mt = 0; mt < 8; ++mt) {
            const int dv0 = 16 * mt + 4 * quad;
            const u32x2 gg = *(const u32x2*)(G + tq * RW + hd * 128 + dv0);
            const f32x4 gn = *(const f32x4*)(gn_g + hd * 128 + dv0);
            const float o0 = (aO[mt][0] - mu) * rstd * gn[0] * silu_f(bf_lo(gg.x)), o1 = (aO[mt][1] - mu) * rstd * gn[1] * silu_f(bf_hi(gg.x));
            const float o2 = (aO[mt][2] - mu) * rstd * gn[2] * silu_f(bf_lo(gg.y)), o3 = (aO[mt][3] - mu) * rstd * gn[3] * silu_f(bf_hi(gg.y));
            u32x2 o; o.x = pk2(o0, o1); o.y = pk2(o2, o3);
            *(u32x2*)(mix + tq * DM + hd * 128 + dv0) = o;
        }
    }
}

DI void conv_phase(const bf16_t* __restrict__ U, const bf16_t* __restrict__ BG, const float* __restrict__ cw, bf16_t* __restrict__ mix, int bid, int nb) {
    for (size_t i = (size_t)bid * 512 + threadIdx.x; i < (size_t)TOK * 128; i += (size_t)nb * 512) {
        const size_t t = i >> 7; const int c8 = (int)(i & 127) * 8, pos = (int)(t & 8191);
        const u32x4 zero = {0u, 0u, 0u, 0u};
        const u32x4 u1 = *(const u32x4*)(U + t * RW + c8);
        const u32x4 u0 = pos > 0 ? *(const u32x4*)(U + (t - 1) * RW + c8) : zero;
        const u32x4 u2 = pos < 8191 ? *(const u32x4*)(U + (t + 1) * RW + c8) : zero;
        const u32x4 bg = *(const u32x4*)(BG + t * RW + c8);
        const f32x4 w0a = *(const f32x4*)(cw + c8), w0b = *(const f32x4*)(cw + c8 + 4), w1a = *(const f32x4*)(cw + 1024 + c8), w1b = *(const f32x4*)(cw + 1024 + c8 + 4),
                    w2a = *(const f32x4*)(cw + 2048 + c8), w2b = *(const f32x4*)(cw + 2048 + c8 + 4);
        float r[8];
#define CV(E, WA, IDX) r[E] = bfelf<E>(bg) * (WA##0[IDX] * bfelf<E>(u0) + WA##1[IDX] * bfelf<E>(u1) + WA##2[IDX] * bfelf<E>(u2));
        { const f32x4 A0 = w0a, A1 = w1a, A2 = w2a, B0 = w0b, B1 = w1b, B2 = w2b;
          CV(0, A, 0) CV(1, A, 1) CV(2, A, 2) CV(3, A, 3) CV(4, B, 0) CV(5, B, 1) CV(6, B, 2) CV(7, B, 3) }
#undef CV
        u32x4 o; o.x = pk2(r[0], r[1]); o.y = pk2(r[2], r[3]); o.z = pk2(r[4], r[5]); o.w = pk2(r[6], r[7]);
        *(u32x4*)(mix + t * DM + 1024 + c8) = o;
    }
}

DI void ln1_phase(const bf16_t* __restrict__ Z, const float* __restrict__ g, const float* __restrict__ b, bf16_t* __restrict__ H, int bid, int nb) {
    const int lane = threadIdx.x & 63, w = threadIdx.x >> 6;
    for (int row = bid * 8 + w; row < TOK; row += nb * 8) {
        u32x4 zv[4]; float v[32];
#pragma unroll
        for (int i = 0; i < 4; ++i) zv[i] = *(const u32x4*)(Z + (size_t)row * DM + (lane + 64 * i) * 8);
        float s = 0.f;
#pragma unroll
        for (int i = 0; i < 4; ++i)
#pragma unroll
            for (int k = 0; k < 4; ++k) { v[8 * i + 2 * k] = bf_lo(zv[i][k]); v[8 * i + 2 * k + 1] = bf_hi(zv[i][k]); s += v[8 * i + 2 * k] + v[8 * i + 2 * k + 1]; }
        s = wave_sum(s); const float mu = s * (1.0f / 2048.0f); float q = 0.f;
#pragma unroll
        for (int k = 0; k < 32; ++k) { const float d = v[k] - mu; q += d * d; }
        q = wave_sum(q); const float rstd = rsqrtf(q * (1.0f / 2048.0f) + 1e-5f);
#pragma unroll
        for (int i = 0; i < 4; ++i) {
            const int c0 = (lane + 64 * i) * 8;
            const f32x4 ga = *(const f32x4*)(g + c0), gb = *(const f32x4*)(g + c0 + 4), ba = *(const f32x4*)(b + c0), bb = *(const f32x4*)(b + c0 + 4);
            u32x4 o;
            o.x = pk2((v[8 * i + 0] - mu) * rstd * ga[0] + ba[0], (v[8 * i + 1] - mu) * rstd * ga[1] + ba[1]);
            o.y = pk2((v[8 * i + 2] - mu) * rstd * ga[2] + ba[2], (v[8 * i + 3] - mu) * rstd * ga[3] + ba[3]);
            o.z = pk2((v[8 * i + 4] - mu) * rstd * gb[0] + bb[0], (v[8 * i + 5] - mu) * rstd * gb[1] + bb[1]);
            o.w = pk2((v[8 * i + 6] - mu) * rstd * gb[2] + bb[2], (v[8 * i + 7] - mu) * rstd * gb[3] + bb[3]);
            *(u32x4*)(H + (size_t)row * DM + c0) = o;
        }
    }
}

#define INS16(r, x) { _Pragma("unroll") for (int j_ = 15; j_ >= 1; --j_) r[j_] = __builtin_amdgcn_fmed3f(r[j_ - 1], r[j_], x); r[0] = fmaxf(r[0], x); }
DI float gelu_f(float x) { return 0.5f * x * (1.0f + erff(x * 0.7071067811865476f)); }

DI void peer_phase(const Params& p, const bf16_t* __restrict__ H, const bf16_t* __restrict__ Ub, const bf16_t* __restrict__ Vb, float* scores_out, unsigned char* lds, int bid, int nb) {
    const int tid = threadIdx.x, lane = tid & 63, w = tid >> 6;
    int* sel_eid = (int*)lds; float* sel_gate = (float*)(lds + 49152);
    for (int grp = bid; grp < 256; grp += nb) {
        __syncthreads();
        for (int row = tid; row < 768; row += 512) {
            const int tl = row >> 3, head = row & 7; const size_t tok = (size_t)grp * 96 + tl;
            const float4* sp = (const float4*)(scores_out + tok * DM + head * 256);
            float r1[16], r2[16];
#pragma unroll
            for (int j = 0; j < 16; ++j) { r1[j] = -INFINITY; r2[j] = -INFINITY; }
            for (int i = 0; i < 32; ++i) {
                const float4 a = sp[i];
                const float x0 = __uint_as_float((__float_as_uint(a.x) & 0xffffff80u) | (unsigned)(4 * i)), x1 = __uint_as_float((__float_as_uint(a.y) & 0xffffff80u) | (unsigned)(4 * i + 1)),
                            x2 = __uint_as_float((__float_as_uint(a.z) & 0xffffff80u) | (unsigned)(4 * i + 2)), x3 = __uint_as_float((__float_as_uint(a.w) & 0xffffff80u) | (unsigned)(4 * i + 3));
                INS16(r1, x0) INS16(r1, x1) INS16(r1, x2) INS16(r1, x3)
            }
            for (int i = 0; i < 32; ++i) {
                const float4 a = sp[32 + i];
                const float x0 = __uint_as_float((__float_as_uint(a.x) & 0xffffff80u) | (unsigned)(4 * i)), x1 = __uint_as_float((__float_as_uint(a.y) & 0xffffff80u) | (unsigned)(4 * i + 1)),
                            x2 = __uint_as_float((__float_as_uint(a.z) & 0xffffff80u) | (unsigned)(4 * i + 2)), x3 = __uint_as_float((__float_as_uint(a.w) & 0xffffff80u) | (unsigned)(4 * i + 3));
                INS16(r2, x0) INS16(r2, x1) INS16(r2, x2) INS16(r2, x3)
            }
            float bk[16]; int bpay[16];
#pragma unroll
            for (int j = 0; j < 16; ++j) { bk[j] = -INFINITY; bpay[j] = 0; }
#pragma unroll
            for (int a = 0; a < 16; ++a)
#pragma unroll
                for (int b = 0; b < 16; ++b)
                    if ((a + 1) * (b + 1) <= 16) {
                        const unsigned ua = __float_as_uint(r1[a]), ub = __float_as_uint(r2[b]);
                        const float key = __uint_as_float(ua & 0xffffff80u) + __uint_as_float(ub & 0xffffff80u);
                        const int pay = (int)(((ua & 127u) << 7) | (ub & 127u));
                        bool chi = key > bk[15];
#pragma unroll
                        for (int j = 15; j >= 1; --j) {
                            const bool cup = key > bk[j - 1];
                            bk[j] = cup ? bk[j - 1] : (chi ? key : bk[j]);
                            bpay[j] = cup ? bpay[j - 1] : (chi ? pay : bpay[j]);
                            chi = cup;
                        }
                        bk[0] = chi ? key : bk[0]; bpay[0] = chi ? pay : bpay[0];
                    }
            float ex[16], ssum = 0.f;
#pragma unroll
            for (int j = 0; j < 16; ++j) { ex[j] = __expf(bk[j] - bk[0]); ssum += ex[j]; }
            const float inv = 1.0f / ssum;
#pragma unroll
            for (int j = 0; j < 16; ++j) { sel_eid[tl * 128 + head * 16 + j] = bpay[j]; sel_gate[tl * 128 + head * 16 + j] = ex[j] * inv; }
        }
        __syncthreads();
        for (int tt = w; tt < 96; tt += 8) {
            const size_t tok = (size_t)grp * 96 + tt;
            u32x4 hv[4];
#pragma unroll
            for (int i = 0; i < 4; ++i) hv[i] = *(const u32x4*)(H + tok * DM + (lane + 64 * i) * 8);
            const int eidA = sel_eid[tt * 128 + lane], eidB = sel_eid[tt * 128 + 64 + lane];
            const float gA = sel_gate[tt * 128 + lane], gB = sel_gate[tt * 128 + 64 + lane];
            float dA = 0.f, dB = 0.f;
            for (int e8 = 0; e8 < 128; e8 += 4) {
                float part[4];
#pragma unroll
                for (int q = 0; q < 4; ++q) {
                    const int e = e8 + q;
                    const int eid = __builtin_amdgcn_readlane(e8 < 64 ? eidA : eidB, e & 63);
                    const bf16_t* up = Ub + (size_t)eid * DM;
                    float a = 0.f;
#pragma unroll
                    for (int i = 0; i < 4; ++i) {
                        const u32x4 uv = *(const u32x4*)(up + (lane + 64 * i) * 8);
                        a = dot2bf(uv.x, hv[i].x, a); a = dot2bf(uv.y, hv[i].y, a); a = dot2bf(uv.z, hv[i].z, a); a = dot2bf(uv.w, hv[i].w, a);
                    }
                    part[q] = a;
                }
#pragma unroll
                for (int q = 0; q < 4; ++q) {
                    const float tot = wave_sum(part[q]); const int e = e8 + q;
                    if (e8 < 64) dA = (lane == e) ? tot : dA; else dB = (lane == e - 64) ? tot : dB;
                }
            }
            const float cA = gA * gelu_f(dA), cB = gB * gelu_f(dB);
            float o[32];
#pragma unroll
            for (int k = 0; k < 32; ++k) o[k] = 0.f;
            for (int e8 = 0; e8 < 128; e8 += 4) {
#pragma unroll
                for (int q = 0; q < 4; ++q) {
                    const int e = e8 + q;
                    const int eid = __builtin_amdgcn_readlane(e8 < 64 ? eidA : eidB, e & 63);
                    const float cf = __int_as_float(__builtin_amdgcn_readlane(__float_as_int(e8 < 64 ? cA : cB), e & 63));
                    const bf16_t* vp = Vb + (size_t)eid * DM;
#pragma unroll
                    for (int i = 0; i < 4; ++i) {
                        const u32x4 vv = *(const u32x4*)(vp + (lane + 64 * i) * 8);
#pragma unroll
                        for (int k = 0; k < 4; ++k) { o[8 * i + 2 * k] += cf * bf_lo(vv[k]); o[8 * i + 2 * k + 1] += cf * bf_hi(vv[k]); }
                    }
                }
            }
            float s = 0.f;
#pragma unroll
            for (int i = 0; i < 4; ++i)
#pragma unroll
                for (int k = 0; k < 4; ++k) { o[8 * i + 2 * k] += ALPHA * bf_lo(hv[i][k]); o[8 * i + 2 * k + 1] += ALPHA * bf_hi(hv[i][k]); s += o[8 * i + 2 * k] + o[8 * i + 2 * k + 1]; }
            s = wave_sum(s); const float mu = s * (1.0f / 2048.0f); float qv = 0.f;
#pragma unroll
            for (int k = 0; k < 32; ++k) { const float d = o[k] - mu; qv += d * d; }
            qv = wave_sum(qv); const float rstd = rsqrtf(qv * (1.0f / 2048.0f) + 1e-5f);
#pragma unroll
            for (int i = 0; i < 4; ++i) {
                const int c0 = (lane + 64 * i) * 8;
                const f32x4 ga = *(const f32x4*)(p.ln2_g + c0), gb = *(const f32x4*)(p.ln2_g + c0 + 4), ba = *(const f32x4*)(p.ln2_b + c0), bb = *(const f32x4*)(p.ln2_b + c0 + 4);
                f32x4 y0, y1;
#pragma unroll
                for (int k = 0; k < 4; ++k) { y0[k] = (o[8 * i + k] - mu) * rstd * ga[k] + ba[k]; y1[k] = (o[8 * i + 4 + k] - mu) * rstd * gb[k] + bb[k]; }
                *(f32x4*)(scores_out + tok * DM + c0) = y0; *(f32x4*)(scores_out + tok * DM + c0 + 4) = y1;
            }
        }
    }
}

__global__ void __launch_bounds__(512) hymba_fwd(Params p) {
    extern __shared__ __attribute__((aligned(16))) unsigned char lds[];
    cg::grid_group grid = cg::this_grid();
    const int bid = blockIdx.x, nb = gridDim.x;
    unsigned char* ws = p.ws;
    bf16_t* xb = (bf16_t*)(ws + WS_R0); bf16_t* mix = (bf16_t*)(ws + WS_R0);
    bf16_t* Ub = (bf16_t*)(ws + WS_R0); bf16_t* Vb = (bf16_t*)(ws + WS_R0 + 64 * MiB);
    bf16_t* Uc = (bf16_t*)(ws + WS_R1); bf16_t* BG = (bf16_t*)(ws + WS_R1 + 48 * MiB); bf16_t* Z = (bf16_t*)(ws + WS_R1);
    bf16_t* KVf = (bf16_t*)(ws + WS_R2); bf16_t* KVb = (bf16_t*)(ws + WS_R2 + 48 * MiB); bf16_t* H = (bf16_t*)(ws + WS_R2);
    bf16_t* Sf = (bf16_t*)(ws + WS_R3); bf16_t* Sb = (bf16_t*)(ws + WS_R3 + 48 * MiB);
    bf16_t* WinT = (bf16_t*)(ws + WS_W); bf16_t* WoutT = (bf16_t*)(ws + WS_W + 28 * MiB); bf16_t* WqkT = (bf16_t*)(ws + WS_W + 36 * MiB);
    bf16_t* Q = (bf16_t*)p.out; bf16_t* K = Q + (size_t)TOK * RW; bf16_t* V = K + (size_t)TOK * RW; bf16_t* G = V + (size_t)TOK * RW;

#ifndef PH_MASK
#define PH_MASK 0xFFFF
#endif
    if (PH_MASK & 1) {
    convert_flat(p.x_prompt, xb, (size_t)8192 * DM / 8, bid, nb);
    convert_flat(p.x_sample, xb + (size_t)8192 * DM, (size_t)16384 * DM / 8, bid, nb);
    transpose_convert<true>(p.w_in, NPROJ, WinT, NPROJ, bid, nb);
    transpose_convert<false>(p.w_out, DM, WoutT, DM, bid, nb);
    fold_phase(p.w_query, p.keys1, p.keys2, WqkT, lds, bid, nb);
    }
    grid.sync();
    if (PH_MASK & 2) {
        pg8::Gemm g{xb, WinT, TOK, NPROJ, DM}; pg8::StaticOrder S; S.init(TOK, NPROJ, nb, bid);
        EpiInProj E{Q, Uc, BG};
        pg8::gemm_phase<EpiInProj, pg8::StaticOrder, false>((PG8_LAS unsigned char*)lds, g, S, E, nullptr);
    }
    grid.sync();
    if (PH_MASK & 4) r1_phase(K, V, KVf, KVb, p.rate_f, p.rate_b, lds, bid, nb);
    grid.sync();
    if (PH_MASK & 8) r2_phase(KVf, KVb, Sf, Sb, p.rate_f, p.rate_b, bid, nb);
    grid.sync();
    if (PH_MASK & 16) r3_phase(Q, K, V, G, Sf, Sb, p.rate_f, p.rate_b, p.gn_g, mix, lds, bid, nb);
    if (PH_MASK & 32) conv_phase(Uc, BG, p.conv_w, mix, bid, nb);
    grid.sync();
    if (PH_MASK & 64) {
        pg8::Gemm g{mix, WoutT, TOK, DM, DM}; pg8::StaticOrder S; S.init(TOK, DM, nb, bid);
        EpiOutProj E{p.x_prompt, p.x_sample, Z};
        pg8::gemm_phase<EpiOutProj, pg8::StaticOrder, false>((PG8_LAS unsigned char*)lds, g, S, E, nullptr);
    }
    grid.sync();
    if (PH_MASK & 128) ln1_phase(Z, p.ln1_g, p.ln1_b, H, bid, nb);
    convert_flat(p.peer_u, Ub, (size_t)16384 * DM / 8, bid, nb);
    convert_flat(p.peer_v, Vb, (size_t)16384 * DM / 8, bid, nb);
    grid.sync();
    if (PH_MASK & 256) {
        pg8::Gemm g{H, WqkT, TOK, DM, DM}; pg8::StaticOrder S; S.init(TOK, DM, nb, bid);
        EpiScore E{p.out};
        pg8::gemm_phase<EpiScore, pg8::StaticOrder, false>((PG8_LAS unsigned char*)lds, g, S, E, nullptr);
    }
    grid.sync();
    if (PH_MASK & 512) peer_phase(p, H, Ub, Vb, p.out, lds, bid, nb);
}

extern "C" void kernel_launch(void* const* d_in, const int* in_sizes, int n_in, void* d_out, int out_size, void* d_ws, size_t ws_size, hipStream_t stream) {
    constexpr int LDS_BYTES = 131072;
    static int grid_blocks = 0;
    if (!grid_blocks) {
        int dev = 0, cus = 0, per_cu = 0;
        hipGetDevice(&dev);
        hipDeviceGetAttribute(&cus, hipDeviceAttributeMultiprocessorCount, dev);
        hipFuncSetAttribute((const void*)hymba_fwd, hipFuncAttributeMaxDynamicSharedMemorySize, LDS_BYTES);
        hipOccupancyMaxActiveBlocksPerMultiprocessor(&per_cu, (const void*)hymba_fwd, 512, LDS_BYTES);
        if (per_cu < 1) per_cu = 1;
        grid_blocks = cus * per_cu;
        if (ws_size < WS_END) fprintf(stderr, "kernel_launch: workspace too small: %zu < %zu\n", ws_size, (size_t)WS_END);
    }
    Params p{};
    const float** pp = (const float**)&p;
    for (int i = 0; i < 17; ++i) pp[i] = (const float*)d_in[i];
    p.out = (float*)d_out; p.ws = (unsigned char*)d_ws;
    void* args[] = {&p};
    hipError_t e = hipLaunchCooperativeKernel((const void*)hymba_fwd, dim3(grid_blocks), dim3(512), args, LDS_BYTES, stream);
    if (e != hipSuccess) fprintf(stderr, "cooperative launch failed: %s (grid %d)\n", hipGetErrorString(e), grid_blocks);
}
```

```cpp
#include <hip/hip_runtime.h>
#include <hip/hip_cooperative_groups.h>
#include <cstdio>
namespace cg = cooperative_groups;
namespace pg8 {
#define PG8_LAS __attribute__((address_space(3)))
typedef unsigned short bf16_t;
typedef short bf16x8 __attribute__((ext_vector_type(8)));
typedef float f32x4 __attribute__((ext_vector_type(4)));
typedef unsigned u32x4 __attribute__((ext_vector_type(4)));
constexpr int BM = 256, BK = 64, HALF = 128, HTB = HALF * BK * 2  , STAGE_BYTES = 8 * HTB, NXCD = 8, WGM = 8;

__host__ __device__ __forceinline__ int lds_byte(int r, int c) { const int st = (r >> 4) * 2 + (c >> 5), rr = r & 15, cc = c & 31, ob = rr * 64 + cc * 2; return st * 1024 + (ob ^ (((ob >> 9) & 1) << 5)); }
__host__ __device__ __forceinline__ void stage_rc(int b, int& R, int& C) { const int st = b / 1024, sb = b % 1024, swz = sb ^ (((sb >> 9) & 1) << 5); R = (st >> 1) * 16 + swz / 64; C = (st & 1) * 32 + (swz % 64) / 2; }
__host__ __device__ __forceinline__ int perm32(int rho) { const int n = rho >> 4, i = rho & 15; return 8 * (i >> 2) + 4 * n + (i & 3); }

struct Unit { int pm, pn; };
struct Gemm { const bf16_t* A; const bf16_t* Bt; int M, N, K; };

struct StaticOrder {
    int nM, nN, nwg, G, c;
    __host__ __device__ void init(int M, int N, int G_, int c_) { nM = M / BM; nN = N / BM; nwg = nM * nN; G = G_; c = c_; }
    __host__ __device__ bool next(int i, Unit& u) const {
        const long L = (long)i * G + c; if (L >= nwg) return false;
        int wgid = (int)L; { const int q = nwg / NXCD, r = nwg % NXCD, xcd = wgid % NXCD, off = wgid / NXCD; wgid = (xcd < r ? xcd * (q + 1) : r * (q + 1) + (xcd - r) * q) + off; }
        const int nig = WGM * nN, gid = wgid / nig, fm = gid * WGM, gsz = (nM - fm) < WGM ? (nM - fm) : WGM;
        u.pm = fm + ((wgid % nig) % gsz); u.pn = (wgid % nig) / gsz; return true;
    }
    __device__ __forceinline__ void a_ready(const Unit&) const {}
    __device__ __forceinline__ void done(const Unit&) const {}
};
template <class Epi, class Sched, bool STAMP = false>
__device__ __forceinline__ void gemm_phase(PG8_LAS unsigned char* lds, const Gemm g, const Sched& S, const Epi& E, unsigned long long* stamps) {
    const int tid = threadIdx.x, wid = __builtin_amdgcn_readfirstlane(tid >> 6), lane = tid & 63, wr = wid >> 2, wc = wid & 3, fr = lane & 15, fq = lane >> 4;
    const int K = g.K, nt = K / BK;
    int ts_lo = 0, ts_hi = 0, nts = 0; const unsigned long long rt_entry = STAMP ? (unsigned long long)wall_clock64() : 0ull;
#define PG8_STAMP() do { if (STAMP && wid == 0 && nts < 64) { const unsigned long long _c = (unsigned long long)clock64(); \
        ts_lo = (lane == nts) ? (int)(unsigned)_c : ts_lo; ts_hi = (lane == nts) ? (int)(unsigned)(_c >> 32) : ts_hi; ++nts; } } while (0)
    PG8_STAMP();
    unsigned voffA[2], voffB[2];
#pragma unroll
    for (int i = 0; i < 2; ++i) { int R, C; stage_rc(tid * 16 + i * 8192, R, C); const int Rb = Epi::PERM ? ((R & ~31) + perm32(R & 31)) : R;
        voffA[i] = (unsigned)(R * K + C) * 2u; voffB[i] = (unsigned)(Rb * K + C) * 2u; }
    const size_t kstep = (size_t)(BK * 2);
    const size_t hstep = (size_t)HALF * K * 2;
    const size_t tstep = 2 * hstep;
    const unsigned ldsw = (unsigned)wid * 1024u;
    const int aoff = lds_byte(wr * 64 + fr, fq * 8), boff = lds_byte(wc * 32 + fr, fq * 8);
#define PG8_SA(b, h) (((b) * 2 + (h)) * HTB)
#define PG8_SB(b, h) ((4 + (b) * 2 + (h)) * HTB)
#define PG8_STAGE(bufoff, gbase, voff) do { _Pragma("unroll") for (int _i = 0; _i < 2; ++_i) \
        __builtin_amdgcn_global_load_lds((const unsigned*)((const char*)(gbase) + (voff)[_i]), (PG8_LAS unsigned*)(lds + (bufoff) + ldsw + _i * 8192), 16, 0, 0); } while (0)
#define PG8_LDA(dst, b, h) do { _Pragma("unroll") for (int m = 0; m < 4; ++m) _Pragma("unroll") for (int k = 0; k < 2; ++k) dst[m][k] = *(const PG8_LAS bf16x8*)(lds + PG8_SA(b, h) + aoff + m * 2048 + k * 1024); } while (0)
#define PG8_LDB(dst, b, h) do { _Pragma("unroll") for (int n = 0; n < 2; ++n) _Pragma("unroll") for (int k = 0; k < 2; ++k) dst[n][k] = *(const PG8_LAS bf16x8*)(lds + PG8_SB(b, h) + boff + n * 2048 + k * 1024); } while (0)
#define PG8_MMA(ai, bj, At, Bt) do { __builtin_amdgcn_s_setprio(1); _Pragma("unroll") for (int m = 0; m < 4; ++m) _Pragma("unroll") for (int n = 0; n < 2; ++n) _Pragma("unroll") for (int k = 0; k < 2; ++k) \
        acc[ai][bj][m][n] = __builtin_amdgcn_mfma_f32_16x16x32_bf16(Bt[n][k], At[m][k], acc[ai][bj][m][n], 0, 0, 0); __builtin_amdgcn_s_setprio(0); } while (0)
#define PG8_WAIT_V(n) asm volatile("s_waitcnt vmcnt(" #n ")" ::: "memory")
#define PG8_WAIT_L(n) asm volatile("s_waitcnt lgkmcnt(" #n ")" ::: "memory")
#define PG8_BAR __builtin_amdgcn_s_barrier()
#define PG8_SCHED __builtin_amdgcn_sched_barrier(0)
    Unit cur, nxt; int ui = 0;
    if (!S.next(0, cur)) return;
    f32x4 acc[2][2][4][2];
#pragma unroll
    for (int a = 0; a < 2; ++a)
#pragma unroll
        for (int b = 0; b < 2; ++b)
#pragma unroll
            for (int m = 0; m < 4; ++m)
#pragma unroll
                for (int n = 0; n < 2; ++n) acc[a][b][m][n] = (f32x4){0.f, 0.f, 0.f, 0.f};
    bf16x8 At[4][2], B0[2][2], B1[2][2];
    const char* cA = (const char*)g.A + (size_t)cur.pm * tstep; const char* cB = (const char*)g.Bt + (size_t)cur.pn * tstep;
    S.a_ready(cur);
    PG8_STAGE(PG8_SB(0, 0), cB, voffB); PG8_STAGE(PG8_SA(0, 0), cA, voffA); PG8_STAGE(PG8_SB(0, 1), cB + hstep, voffB); PG8_STAGE(PG8_SA(0, 1), cA + hstep, voffA);
    if (wr == 1) PG8_BAR;
    PG8_WAIT_V(4); PG8_BAR;
    PG8_STAGE(PG8_SB(1, 0), cB + kstep, voffB); PG8_STAGE(PG8_SA(1, 0), cA + kstep, voffA); PG8_STAGE(PG8_SB(1, 1), cB + hstep + kstep, voffB);
    PG8_WAIT_V(6); PG8_BAR;
    PG8_STAMP();
    for (;;) {
        const bool has_next = S.next(ui + 1, nxt);
        const char* nA = has_next ? (const char*)g.A + (size_t)nxt.pm * tstep : cA; const char* nB = has_next ? (const char*)g.Bt + (size_t)nxt.pn * tstep : cB;
        for (int t = 0; t < nt; t += 2) {
            const bool last = (t == nt - 2);
            const char* a1 = cA + (size_t)(t + 1) * kstep;
            const char* a2 = last ? nA : cA + (size_t)(t + 2) * kstep; const char* b2 = last ? nB : cB + (size_t)(t + 2) * kstep;
            const char* a3 = a2 + kstep; const char* b3 = b2 + kstep;
            if (last && has_next) S.a_ready(nxt);
            PG8_LDB(B0, 0, 0); PG8_SCHED; PG8_LDA(At, 0, 0); PG8_STAGE(PG8_SA(1, 1), a1 + hstep, voffA);
            PG8_WAIT_L(8); PG8_BAR; PG8_WAIT_L(0); PG8_MMA(0, 0, At, B0); PG8_BAR; PG8_SCHED;
            PG8_LDB(B1, 0, 1); PG8_STAGE(PG8_SB(0, 0), b2, voffB);
            PG8_BAR; PG8_WAIT_L(0); PG8_MMA(0, 1, At, B1); PG8_BAR;
            PG8_LDA(At, 0, 1); PG8_STAGE(PG8_SA(0, 0), a2, voffA);
            PG8_BAR; PG8_WAIT_L(0); PG8_MMA(1, 0, At, B0); PG8_BAR; PG8_SCHED;
            PG8_STAGE(PG8_SB(0, 1), b2 + hstep, voffB);
            PG8_WAIT_V(6); PG8_BAR; PG8_MMA(1, 1, At, B1); PG8_BAR;
            PG8_LDB(B0, 1, 0); PG8_SCHED; PG8_LDA(At, 1, 0); PG8_STAGE(PG8_SA(0, 1), a2 + hstep, voffA);
            PG8_WAIT_L(8); PG8_BAR; PG8_WAIT_L(0); PG8_MMA(0, 0, At, B0); PG8_BAR; PG8_SCHED;
            PG8_LDB(B1, 1, 1); PG8_STAGE(PG8_SB(1, 0), b3, voffB);
            PG8_BAR; PG8_WAIT_L(0); PG8_MMA(0, 1, At, B1); PG8_BAR;
            PG8_LDA(At, 1, 1); PG8_STAGE(PG8_SA(1, 0), a3, voffA);
            PG8_BAR; PG8_WAIT_L(0); PG8_MMA(1, 0, At, B0); PG8_BAR; PG8_SCHED;
            PG8_STAGE(PG8_SB(1, 1), b3 + hstep, voffB);
            PG8_WAIT_V(6); PG8_BAR; PG8_MMA(1, 1, At, B1); PG8_BAR;
        }
        PG8_STAMP();
        if constexpr (!Epi::AFTER_DRAIN) { E(acc, cur, wr, wc, fr, fq); S.done(cur); }
        PG8_STAMP();
        if (!has_next) break;
#pragma unroll
        for (int a = 0; a < 2; ++a)
#pragma unroll
            for (int b = 0; b < 2; ++b)
#pragma unroll
                for (int m = 0; m < 4; ++m)
#pragma unroll
                    for (int n = 0; n < 2; ++n) acc[a][b][m][n] = (f32x4){0.f, 0.f, 0.f, 0.f};
        cur = nxt; cA = nA; cB = nB; ++ui;
    }
    PG8_WAIT_V(0);
    if (wr == 0) PG8_BAR;
    PG8_BAR;
    if constexpr (Epi::AFTER_DRAIN) { E.fused(acc, cur, wr, wc, fr, fq, lds, wid, lane); S.done(cur); }
    PG8_STAMP();
    if (STAMP && wid == 0) { stamps[lane] = lane < nts ? (((unsigned long long)(unsigned)ts_hi << 32) | (unsigned)ts_lo) : 0ull;
        if (lane == 62) stamps[62] = rt_entry; if (lane == 63) stamps[63] = (unsigned long long)wall_clock64(); }
#undef PG8_STAMP
#undef PG8_SA
#undef PG8_SB
#undef PG8_STAGE
#undef PG8_LDA
#undef PG8_LDB
#undef PG8_MMA
#undef PG8_WAIT_V
#undef PG8_WAIT_L
#undef PG8_BAR
#undef PG8_SCHED
}
}

using pg8::bf16_t; using pg8::bf16x8; using pg8::f32x4; using pg8::u32x4;
typedef unsigned u32x2 __attribute__((ext_vector_type(2)));
typedef __bf16 bf16x2_t __attribute__((ext_vector_type(2)));
typedef float f32x2_t __attribute__((ext_vector_type(2)));
#define DI __device__ __forceinline__

constexpr int TOK = 24576, DM = 2048, NPROJ = 7168, RW = 1024;
constexpr float ALPHA = 1.189207115002721f;
constexpr float LOG2E = 1.4426950408889634f;
constexpr size_t MiB = 1048576;
constexpr size_t WS_R0 = 0;
constexpr size_t WS_R1 = 128 * MiB;
constexpr size_t WS_R2 = 224 * MiB;
constexpr size_t WS_R3 = 320 * MiB;
constexpr size_t WS_W  = 416 * MiB;
constexpr size_t WS_END = 460 * MiB;

struct Params {
    const float *x_prompt, *x_sample, *w_in, *rate_f, *rate_b, *gn_g, *conv_w, *w_out, *ln1_g, *ln1_b, *w_query, *keys1, *keys2, *peer_u, *peer_v, *ln2_g, *ln2_b;
    float* out; unsigned char* ws;
};

DI unsigned pk2(float a, float b) { f32x2_t v = {a, b}; return __builtin_bit_cast(unsigned, __builtin_convertvector(v, bf16x2_t)); }
DI float bf_lo(unsigned w) { return __uint_as_float(w << 16); }
DI float bf_hi(unsigned w) { return __uint_as_float(w & 0xffff0000u); }
DI f32x4 mfma16(bf16x8 a, bf16x8 b, f32x4 c) { return __builtin_amdgcn_mfma_f32_16x16x32_bf16(a, b, c, 0, 0, 0); }
DI float wave_sum(float x) { x += __shfl_xor(x, 1); x += __shfl_xor(x, 2); x += __shfl_xor(x, 4); x += __shfl_xor(x, 8); x += __shfl_xor(x, 16); x += __shfl_xor(x, 32); return x; }
DI float dot2bf(unsigned a, unsigned b, float c) { return __builtin_amdgcn_fdot2_f32_bf16(__builtin_bit_cast(bf16x2_t, a), __builtin_bit_cast(bf16x2_t, b), c, false); }
DI const float* xrow(const Params& p, int tok) { return tok < 8192 ? p.x_prompt + (size_t)tok * DM : p.x_sample + (size_t)(tok - 8192) * DM; }

DI int map_inproj(int c) {
    if (c < 2048) { const int blk = c >> 7, cc = c & 127, g = cc >> 3, j = cc & 7; return blk * 128 + 4 * g + (j & 3) + 64 * (j >> 2); }
    if (c < 4096) return c;
    if (c < 6144) { const int t = (c - 4096) >> 8, wi = (c - 4096) & 255, half = wi >> 7, col = wi & 127; return (half ? 6144 : 4096) + 128 * t + col; }
    return 5120 + (c - 6144);
}
template <bool MAPPED> DI void transpose_convert(const float* __restrict__ src, int ld, bf16_t* __restrict__ dst, int N, int bid, int nb) {
    const int lane = threadIdx.x & 63, w = threadIdx.x >> 6, nch = N / 256;
    for (int it = bid; it < nch * 32; it += nb) {
        const int chi = it % nch, k8hi = it / nch, c = chi * 256 + lane * 4, k8 = k8hi * 8 + w;
        const int sc = MAPPED ? map_inproj(c) : c;
        const float* sp = src + (size_t)(k8 * 8) * ld + sc;
        f32x4 v[8];
#pragma unroll
        for (int i = 0; i < 8; ++i) v[i] = *(const f32x4*)(sp + (size_t)i * ld);
#pragma unroll
        for (int cc = 0; cc < 4; ++cc) {
            u32x4 o; o.x = pk2(v[0][cc], v[1][cc]); o.y = pk2(v[2][cc], v[3][cc]); o.z = pk2(v[4][cc], v[5][cc]); o.w = pk2(v[6][cc], v[7][cc]);
            *(u32x4*)(dst + (size_t)(c + cc) * 2048 + k8 * 8) = o;
        }
    }
}
DI void convert_flat(const float* __restrict__ src, bf16_t* __restrict__ dst, size_t n8, int bid, int nb) {
    for (size_t i = (size_t)bid * 512 + threadIdx.x; i < n8; i += (size_t)nb * 512) {
        const float4 a = *(const float4*)(src + i * 8), b = *(const float4*)(src + i * 8 + 4);
        u32x4 o; o.x = pk2(a.x, a.y); o.y = pk2(a.z, a.w); o.z = pk2(b.x, b.y); o.w = pk2(b.z, b.w);
        *(u32x4*)(dst + i * 8) = o;
    }
}
DI void fold_phase(const float* __restrict__ wq, const float* __restrict__ k1, const float* __restrict__ k2, bf16_t* __restrict__ WqkT, unsigned char* lds, int bid, int nb) {
    float* sK = (float*)lds; float* sW = sK + 128 * 132;
    const int tid = threadIdx.x;
    for (int it = bid; it < 512; it += nb) {
        const int hh = it >> 5, kt = it & 31, head = hh >> 1, half = hh & 1;
        const float* keys = (half ? k2 : k1) + (size_t)head * 16384;
        __syncthreads();
        for (int p = tid; p < 4096; p += 512) { const int n = p >> 5, d4 = p & 31; *(float4*)(sK + n * 132 + d4 * 4) = *(const float4*)(keys + n * 128 + d4 * 4); }
        for (int p = tid; p < 2048; p += 512) { const int kk = p >> 5, d4 = p & 31; *(float4*)(sW + kk * 132 + d4 * 4) = *(const float4*)(wq + (size_t)(kt * 64 + kk) * 2048 + hh * 128 + d4 * 4); }
        __syncthreads();
        const int n = tid & 63, kq = tid >> 6;
        float acc0[8], acc1[8];
#pragma unroll
        for (int i = 0; i < 8; ++i) { acc0[i] = 0.f; acc1[i] = 0.f; }
        for (int d4 = 0; d4 < 32; ++d4) {
            const float4 ka = *(const float4*)(sK + n * 132 + d4 * 4), kb = *(const float4*)(sK + (n + 64) * 132 + d4 * 4);
#pragma unroll
            for (int i = 0; i < 8; ++i) { const float4 wv = *(const float4*)(sW + (kq * 8 + i) * 132 + d4 * 4);
                acc0[i] += ka.x * wv.x + ka.y * wv.y + ka.z * wv.z + ka.w * wv.w; acc1[i] += kb.x * wv.x + kb.y * wv.y + kb.z * wv.z + kb.w * wv.w; }
        }
        bf16_t* dst = WqkT + (size_t)(hh * 128 + n) * 2048 + kt * 64 + kq * 8;
        u32x4 o0, o1; o0.x = pk2(acc0[0], acc0[1]); o0.y = pk2(acc0[2], acc0[3]); o0.z = pk2(acc0[4], acc0[5]); o0.w = pk2(acc0[6], acc0[7]);
        o1.x = pk2(acc1[0], acc1[1]); o1.y = pk2(acc1[2], acc1[3]); o1.z = pk2(acc1[4], acc1[5]); o1.w = pk2(acc1[6], acc1[7]);
        *(u32x4*)dst = o0; *(u32x4*)(dst + (size_t)64 * 2048) = o1;
    }
}

struct EpiInProj {
    static constexpr bool PERM = true, AFTER_DRAIN = false;
    bf16_t *Q, *U, *BG;
    __device__ __forceinline__ void operator()(const f32x4 (&acc)[2][2][4][2], const pg8::Unit& u, int wr, int wc, int fr, int fq) const {
        const int pn = u.pn, row0 = u.pm * 256 + wr * 64 + fr, cl = wc * 32 + 8 * fq;
        if (pn < 8) {
            bf16_t* dst = Q + (size_t)(pn >> 2) * ((size_t)TOK * RW); const float sc = pn < 4 ? 1.0f : 0.08838834764831845f; const int colbase = (pn & 3) * 256 + cl;
            float cf[4];
#pragma unroll
            for (int e = 0; e < 4; ++e) cf[e] = exp2f(-(float)(cl / 2 + e) * 0.20762050593046014f) * 0.15915494309189535f;
#pragma unroll
            for (int ai = 0; ai < 2; ++ai)
#pragma unroll
                for (int m = 0; m < 4; ++m) {
                    const int row = row0 + ai * 128 + m * 16; const float pos = (float)(row & 8191);
                    float cs[4], sn[4];
#pragma unroll
                    for (int e = 0; e < 4; ++e) { const float pp = pos * cf[e], er = fmaf(pos, cf[e], -pp), frv = (pp - floorf(pp)) + er; sn[e] = __builtin_amdgcn_sinf(frv); cs[e] = __builtin_amdgcn_cosf(frv); }
#pragma unroll
                    for (int bj = 0; bj < 2; ++bj) {
                        const f32x4 x1 = acc[ai][bj][m][0], x2 = acc[ai][bj][m][1]; float o1[4], o2[4];
#pragma unroll
                        for (int e = 0; e < 4; ++e) { o1[e] = (x1[e] * cs[e] - x2[e] * sn[e]) * sc; o2[e] = (x1[e] * sn[e] + x2[e] * cs[e]) * sc; }
                        u32x4 w; w.x = pk2(o1[0], o1[1]); w.y = pk2(o1[2], o1[3]); w.z = pk2(o2[0], o2[1]); w.w = pk2(o2[2], o2[3]);
                        *(u32x4*)(dst + (size_t)row * RW + colbase + bj * 128) = w;
                    }
                }
        } else if (pn < 16 || pn >= 24) {
            bf16_t* dst = pn < 16 ? Q + (size_t)(pn >> 2) * ((size_t)TOK * RW) : BG; const int colbase = (pn & 3) * 256 + cl;
#pragma unroll
            for (int ai = 0; ai < 2; ++ai)
#pragma unroll
                for (int m = 0; m < 4; ++m) {
                    const int row = row0 + ai * 128 + m * 16;
#pragma unroll
                    for (int bj = 0; bj < 2; ++bj) {
                        const f32x4 v0 = acc[ai][bj][m][0], v1 = acc[ai][bj][m][1];
                        u32x4 w; w.x = pk2(v0[0], v0[1]); w.y = pk2(v0[2], v0[3]); w.z = pk2(v1[0], v1[1]); w.w = pk2(v1[2], v1[3]);
                        *(u32x4*)(dst + (size_t)row * RW + colbase + bj * 128) = w;
                    }
                }
        } else {
            const int colbase = (pn - 16) * 128 + cl;
#pragma unroll
            for (int ai = 0; ai < 2; ++ai)
#pragma unroll
                for (int m = 0; m < 4; ++m) {
                    const int row = row0 + ai * 128 + m * 16;
                    const f32x4 v0 = acc[ai][0][m][0] * acc[ai][1][m][0], v1 = acc[ai][0][m][1] * acc[ai][1][m][1];
                    u32x4 w; w.x = pk2(v0[0], v0[1]); w.y = pk2(v0[2], v0[3]); w.z = pk2(v1[0], v1[1]); w.w = pk2(v1[2], v1[3]);
                    *(u32x4*)(U + (size_t)row * RW + colbase) = w;
                }
        }
    }
};
struct EpiOutProj {
    static constexpr bool PERM = true, AFTER_DRAIN = false;
    bf16_t* Z;
    __device__ __forceinline__ void operator()(const f32x4 (&acc)[2][2][4][2], const pg8::Unit& u, int wr, int wc, int fr, int fq) const {
        const int row0 = u.pm * 256 + wr * 64 + fr, col0 = u.pn * 256 + wc * 32 + 8 * fq;
#pragma unroll
        for (int ai = 0; ai < 2; ++ai)
#pragma unroll
            for (int m = 0; m < 4; ++m) {
                const int row = row0 + ai * 128 + m * 16;
#pragma unroll
                for (int bj = 0; bj < 2; ++bj) {
                    const f32x4 v0 = acc[ai][bj][m][0], v1 = acc[ai][bj][m][1];
                    u32x4 w; w.x = pk2(v0[0], v0[1]); w.y = pk2(v0[2], v0[3]); w.z = pk2(v1[0], v1[1]); w.w = pk2(v1[2], v1[3]);
                    *(u32x4*)(Z + (size_t)row * DM + col0 + bj * 128) = w;
                }
            }
    }
};
struct EpiScore {
    static constexpr bool PERM = false, AFTER_DRAIN = false;
    float* C;
    __device__ __forceinline__ void operator()(const f32x4 (&acc)[2][2][4][2], const pg8::Unit& u, int wr, int wc, int fr, int fq) const {
        const int row0 = u.pm * 256 + wr * 64 + fr, col0 = u.pn * 256 + wc * 32 + 4 * fq;
#pragma unroll
        for (int ai = 0; ai < 2; ++ai)
#pragma unroll
            for (int m = 0; m < 4; ++m) { float* rowp = C + (size_t)(row0 + ai * 128 + m * 16) * DM + col0;
#pragma unroll
                for (int bj = 0; bj < 2; ++bj)
#pragma unroll
                    for (int n = 0; n < 2; ++n) *(f32x4*)(rowp + bj * 128 + n * 16) = acc[ai][bj][m][n]; }
    }
};

DI unsigned tile_off(int r, int j) { return (unsigned)(r * 256 + ((((j >> 3) ^ (r & 15))) << 4) + (j & 7) * 2); }
template <int E> DI unsigned short bfel(const u32x4& v) { const unsigned w = v[E >> 1]; return (unsigned short)((E & 1) ? (w >> 16) : (w & 0xffffu)); }
template <int E> DI float bfelf(const u32x4& v) { const unsigned w = v[E >> 1]; return (E & 1) ? bf_hi(w) : bf_lo(w); }

DI void r1_phase(const bf16_t* __restrict__ K, const bf16_t* __restrict__ V, bf16_t* __restrict__ KVf, bf16_t* __restrict__ KVb, const float* rate_f, const float* rate_b,
                 unsigned char* lds, int bid, int nb) {
    const int tid = threadIdx.x, lane = tid & 63, w = tid >> 6, m16 = lane & 15, quad = lane >> 4;
    unsigned char* sKf = lds; unsigned char* sKb = lds + 32768; unsigned char* sV = lds + 65536;
    for (int item = bid; item < 1536; item += nb) {
        const int hd = item & 7; const size_t T0 = (size_t)(item >> 3) * 128;
        const float lgf = -__expf(rate_f[hd]) * LOG2E, lgb = -__expf(rate_b[hd]) * LOG2E;
        __syncthreads();
#pragma unroll
        for (int i = 0; i < 2; ++i) {
            const int p = tid + 512 * i, j = (p >> 4) * 2, d8 = p & 15;
            const bf16_t* kp = K + (T0 + j) * RW + hd * 128 + d8 * 8; const bf16_t* vp = V + (T0 + j) * RW + hd * 128 + d8 * 8;
            const u32x4 k0 = *(const u32x4*)kp, k1 = *(const u32x4*)(kp + RW), v0 = *(const u32x4*)vp, v1 = *(const u32x4*)(vp + RW);
            const float zf0 = exp2f(lgf * (float)(127 - j)), zf1 = exp2f(lgf * (float)(126 - j)), zb0 = exp2f(lgb * (float)j), zb1 = exp2f(lgb * (float)(j + 1));
#define R1_EL(E) { const int d = d8 * 8 + E; const unsigned off = tile_off(d, j); const float ka = bfelf<E>(k0), kb = bfelf<E>(k1); \
                *(unsigned*)(sKf + off) = pk2(ka * zf0, kb * zf1); *(unsigned*)(sKb + off) = pk2(ka * zb0, kb * zb1); \
                *(unsigned*)(sV + off) = (unsigned)bfel<E>(v0) | ((unsigned)bfel<E>(v1) << 16); }
            R1_EL(0) R1_EL(1) R1_EL(2) R1_EL(3) R1_EL(4) R1_EL(5) R1_EL(6) R1_EL(7)
#undef R1_EL
        }
        __syncthreads();
        f32x4 af[8], ab[8];
#pragma unroll
        for (int mt = 0; mt < 8; ++mt) { af[mt] = (f32x4){0.f, 0.f, 0.f, 0.f}; ab[mt] = (f32x4){0.f, 0.f, 0.f, 0.f}; }
#pragma unroll
        for (int ks = 0; ks < 4; ++ks) {
            const int vr = 16 * w + m16;
            const bf16x8 bv = *(const bf16x8*)(sV + vr * 256 + ((((4 * ks + quad) ^ (vr & 15))) << 4));
#pragma unroll
            for (int mt = 0; mt < 8; ++mt) {
                const int r = 16 * mt + m16; const unsigned o = r * 256 + ((((4 * ks + quad) ^ (r & 15))) << 4);
                const bf16x8 a_f = *(const bf16x8*)(sKf + o), a_b = *(const bf16x8*)(sKb + o);
                af[mt] = mfma16(a_f, bv, af[mt]); ab[mt] = mfma16(a_b, bv, ab[mt]);
            }
        }
        const size_t ob = (size_t)item * 16384 + (size_t)(16 * w + m16) * 128 + 4 * quad;
#pragma unroll
        for (int mt = 0; mt < 8; ++mt) {
            u32x2 a; a.x = pk2(af[mt][0], af[mt][1]); a.y = pk2(af[mt][2], af[mt][3]); *(u32x2*)(KVf + ob + 16 * mt) = a;
            u32x2 b; b.x = pk2(ab[mt][0], ab[mt][1]); b.y = pk2(ab[mt][2], ab[mt][3]); *(u32x2*)(KVb + ob + 16 * mt) = b;
        }
    }
}

DI void r2_phase(const bf16_t* __restrict__ KVf, const bf16_t* __restrict__ KVb, bf16_t* __restrict__ Sf, bf16_t* __restrict__ Sb, const float* rate_f, const float* rate_b, int bid, int nb) {
    for (int g = bid * 512 + threadIdx.x; g < 98304; g += nb * 512) {
        const int dir = g / 49152, rem = g % 49152, sh = rem >> 11, piece = rem & 2047, s = sh >> 3, hd = sh & 7;
        const float lg = -__expf((dir ? rate_b : rate_f)[hd]) * LOG2E, Gc = exp2f(lg * 128.f);
        const bf16_t* src = dir ? KVb : KVf; bf16_t* dst = dir ? Sb : Sf;
        float st[8];
#pragma unroll
        for (int e = 0; e < 8; ++e) st[e] = 0.f;
        for (int cc = 0; cc < 64; ++cc) {
            const int c = dir ? 63 - cc : cc;
            const size_t off = ((size_t)((s * 64 + c) * 8 + hd)) * 16384 + (size_t)piece * 8;
            const u32x4 kv = *(const u32x4*)(src + off);
            u32x4 o; o.x = pk2(st[0], st[1]); o.y = pk2(st[2], st[3]); o.z = pk2(st[4], st[5]); o.w = pk2(st[6], st[7]);
            *(u32x4*)(dst + off) = o;
            st[0] = st[0] * Gc + bf_lo(kv.x); st[1] = st[1] * Gc + bf_hi(kv.x); st[2] = st[2] * Gc + bf_lo(kv.y); st[3] = st[3] * Gc + bf_hi(kv.y);
            st[4] = st[4] * Gc + bf_lo(kv.z); st[5] = st[5] * Gc + bf_hi(kv.z); st[6] = st[6] * Gc + bf_lo(kv.w); st[7] = st[7] * Gc + bf_hi(kv.w);
        }
    }
}

DI float silu_f(float x) { return x * __builtin_amdgcn_rcpf(1.0f + __builtin_amdgcn_exp2f(-x * LOG2E)); }

DI void r3_phase(const bf16_t* __restrict__ Q, const bf16_t* __restrict__ K, const bf16_t* __restrict__ V, const bf16_t* __restrict__ G, const bf16_t* __restrict__ Sf, const bf16_t* __restrict__ Sb,
                 const float* rate_f, const float* rate_b, const float* __restrict__ gn_g, bf16_t* __restrict__ mix, unsigned char* lds, int bid, int nb) {
    const int tid = threadIdx.x, lane = tid & 63, w = tid >> 6, m16 = lane & 15, quad = lane >> 4;
    unsigned char* sV = lds; unsigned char* sK = lds + 32768; unsigned char* sSf = lds + 65536; unsigned char* sSb = lds + 98304;
    for (int item = bid; item < 1536; item += nb) {
        const int hd = item & 7; const size_t T0 = (size_t)(item >> 3) * 128;
        const float lgf = -__expf(rate_f[hd]) * LOG2E, lgb = -__expf(rate_b[hd]) * LOG2E;
        __syncthreads();
#pragma unroll
        for (int i = 0; i < 4; ++i) {
            const int p = tid + 512 * i, r = p >> 4, c16 = p & 15;
            const unsigned o = (unsigned)(r * 256 + ((c16 ^ (r & 15)) << 4));
            *(u32x4*)(sK + o) = *(const u32x4*)(K + (T0 + r) * RW + hd * 128 + c16 * 8);
            *(u32x4*)(sSf + o) = *(const u32x4*)(Sf + (size_t)item * 16384 + r * 128 + c16 * 8);
            *(u32x4*)(sSb + o) = *(const u32x4*)(Sb + (size_t)item * 16384 + r * 128 + c16 * 8);
        }
#pragma unroll
        for (int i = 0; i < 2; ++i) {
            const int p = tid + 512 * i, j = (p >> 4) * 2, d8 = p & 15;
            const bf16_t* vp = V + (T0 + j) * RW + hd * 128 + d8 * 8;
            const u32x4 v0 = *(const u32x4*)vp, v1 = *(const u32x4*)(vp + RW);
#define R3_EL(E) { *(unsigned*)(sV + tile_off(d8 * 8 + E, j)) = (unsigned)bfel<E>(v0) | ((unsigned)bfel<E>(v1) << 16); }
            R3_EL(0) R3_EL(1) R3_EL(2) R3_EL(3) R3_EL(4) R3_EL(5) R3_EL(6) R3_EL(7)
#undef R3_EL
        }
        const int il = 16 * w + m16;
        const size_t tq = T0 + il;
        bf16x8 bq[4];
#pragma unroll
        for (int ks = 0; ks < 4; ++ks) bq[ks] = *(const bf16x8*)(Q + tq * RW + hd * 128 + 32 * ks + 8 * quad);
        __syncthreads();
        f32x4 aS[8];
#pragma unroll
        for (int mt = 0; mt < 8; ++mt) aS[mt] = (f32x4){0.f, 0.f, 0.f, 0.f};
#pragma unroll
        for (int ks = 0; ks < 4; ++ks)
#pragma unroll
            for (int mt = 0; mt < 8; ++mt) {
                const int r = 16 * mt + m16;
                const bf16x8 ak = *(const bf16x8*)(sK + r * 256 + ((((4 * ks + quad) ^ (r & 15))) << 4));
                aS[mt] = mfma16(ak, bq[ks], aS[mt]);
            }
        bf16x8 bp[4];
#pragma unroll
        for (int s = 0; s < 4; ++s) {
            float pv[8];
#pragma unroll
            for (int t = 0; t < 8; ++t) {
                const int mt = 2 * s + (t >> 2), r = t & 3, j = 16 * mt + 4 * quad + r, dl = il - j;
                const float dec = dl > 0 ? __builtin_amdgcn_exp2f(lgf * (float)dl) : (dl < 0 ? __builtin_amdgcn_exp2f(lgb * (float)(-dl)) : 2.0f);
                pv[t] = aS[mt][r] * dec;
            }
            u32x4 pk; pk.x = pk2(pv[0], pv[1]); pk.y = pk2(pv[2], pv[3]); pk.z = pk2(pv[4], pv[5]); pk.w = pk2(pv[6], pv[7]);
            bp[s] = __builtin_bit_cast(bf16x8, pk);
        }
        f32x4 aO[8];
#pragma unroll
        for (int mt = 0; mt < 8; ++mt) aO[mt] = (f32x4){0.f, 0.f, 0.f, 0.f};
#pragma unroll
        for (int s = 0; s < 4; ++s)
#pragma unroll
            for (int mt = 0; mt < 8; ++mt) {
                const int row = 16 * mt + m16;
                const u32x2 lo = *(const u32x2*)(sV + row * 256 + ((((4 * s + (quad >> 1)) ^ (row & 15))) << 4) + (quad & 1) * 8);
                const u32x2 hi = *(const u32x2*)(sV + row * 256 + ((((4 * s + 2 + (quad >> 1)) ^ (row & 15))) << 4) + (quad & 1) * 8);
                u32x4 av; av.x = lo.x; av.y = lo.y; av.z = hi.x; av.w = hi.y;
                aO[mt] = mfma16(__builtin_bit_cast(bf16x8, av), bp[s], aO[mt]);
            }
#pragma unroll
        for (int dir = 0; dir < 2; ++dir) {
            const unsigned char* sS = dir ? sSb : sSf;
            f32x4 aX[8];
#pragma unroll
            for (int mt = 0; mt < 8; ++mt) aX[mt] = (f32x4){0.f, 0.f, 0.f, 0.f};
#pragma unroll
            for (int ks = 0; ks < 4; ++ks)
#pragma unroll
                for (int mt = 0; mt < 8; ++mt) {
                    const int r = 16 * mt + m16;
                    const bf16x8 a = *(const bf16x8*)(sS + r * 256 + ((((4 * ks + quad) ^ (r & 15))) << 4));
                    aX[mt] = mfma16(a, bq[ks], aX[mt]);
                }
            const float xi = dir ? exp2f(lgb * (float)(128 - il)) : exp2f(lgf * (float)(il + 1));
#pragma unroll
            for (int mt = 0; mt < 8; ++mt) aO[mt] += xi * aX[mt];
        }
        float sum = 0.f;
#pragma unroll
        for (int mt = 0; mt < 8; ++mt) sum += (aO[mt][0] + aO[mt][1]) + (aO[mt][2] + aO[mt][3]);
        sum += __shfl_xor(sum, 16); sum += __shfl_xor(sum, 32);
        const float mu = sum * (1.0f / 128.0f); float qv = 0.f;
#pragma unroll
        for (int mt = 0; mt < 8; ++mt) { const f32x4 d = aO[mt] - mu; qv += (d[0] * d[0] + d[1] * d[1]) + (d[2] * d[2] + d[3] * d[3]); }
        qv += __shfl_xor(qv, 16); qv += __shfl_xor(qv, 32);
        const float rstd = rsqrtf(qv * (1.0f / 128.0f) + 1e-6f);
#pragma unroll
        for (int mt = 0; mt < 8; ++mt) {
            const int dv0 = 16 * mt + 4 * quad;
            const u32x2 gg = *(const u32x2*)(G + tq * RW + hd * 128 + dv0); const f32x4 gn = *(const f32x4*)(gn_g + hd * 128 + dv0);
            const float o0 = (aO[mt][0] - mu) * rstd * gn[0] * silu_f(bf_lo(gg.x)), o1 = (aO[mt][1] - mu) * rstd * gn[1] * silu_f(bf_hi(gg.x));
            const float o2 = (aO[mt][2] - mu) * rstd * gn[2] * silu_f(bf_lo(gg.y)), o3 = (aO[mt][3] - mu) * rstd * gn[3] * silu_f(bf_hi(gg.y));
            u32x2 o; o.x = pk2(o0, o1); o.y = pk2(o2, o3);
            *(u32x2*)(mix + tq * DM + hd * 128 + dv0) = o;
        }
    }
}

DI void conv_phase(const bf16_t* __restrict__ U, const bf16_t* __restrict__ BG, const float* __restrict__ cw, bf16_t* __restrict__ mix, int bid, int nb) {
    for (size_t i = (size_t)bid * 512 + threadIdx.x; i < (size_t)TOK * 128; i += (size_t)nb * 512) {
        const size_t t = i >> 7; const int c8 = (int)(i & 127) * 8, pos = (int)(t & 8191);
        const u32x4 zero = {0u, 0u, 0u, 0u};
        const u32x4 u1 = *(const u32x4*)(U + t * RW + c8);
        const u32x4 u0 = pos > 0 ? *(const u32x4*)(U + (t - 1) * RW + c8) : zero;
        const u32x4 u2 = pos < 8191 ? *(const u32x4*)(U + (t + 1) * RW + c8) : zero;
        const u32x4 bg = *(const u32x4*)(BG + t * RW + c8);
        const f32x4 w0a = *(const f32x4*)(cw + c8), w0b = *(const f32x4*)(cw + c8 + 4), w1a = *(const f32x4*)(cw + 1024 + c8), w1b = *(const f32x4*)(cw + 1024 + c8 + 4),
                    w2a = *(const f32x4*)(cw + 2048 + c8), w2b = *(const f32x4*)(cw + 2048 + c8 + 4);
        float r[8];
#define CV(E, WA, IDX) r[E] = bfelf<E>(bg) * (WA##0[IDX] * bfelf<E>(u0) + WA##1[IDX] * bfelf<E>(u1) + WA##2[IDX] * bfelf<E>(u2));
        { const f32x4 A0 = w0a, A1 = w1a, A2 = w2a, B0 = w0b, B1 = w1b, B2 = w2b;
          CV(0, A, 0) CV(1, A, 1) CV(2, A, 2) CV(3, A, 3) CV(4, B, 0) CV(5, B, 1) CV(6, B, 2) CV(7, B, 3) }
#undef CV
        u32x4 o; o.x = pk2(r[0], r[1]); o.y = pk2(r[2], r[3]); o.z = pk2(r[4], r[5]); o.w = pk2(r[6], r[7]);
        *(u32x4*)(mix + t * DM + 1024 + c8) = o;
    }
}

DI void ln1_phase(const bf16_t* __restrict__ Z, const bf16_t* __restrict__ X, const float* __restrict__ g, const float* __restrict__ b, bf16_t* __restrict__ H, int bid, int nb) {
    const int lane = threadIdx.x & 63, w = threadIdx.x >> 6;
    for (int row = bid * 8 + w; row < TOK; row += nb * 8) {
        u32x4 zv[4], xv[4]; float v[32];
#pragma unroll
        for (int i = 0; i < 4; ++i) { zv[i] = *(const u32x4*)(Z + (size_t)row * DM + (lane + 64 * i) * 8); xv[i] = *(const u32x4*)(X + (size_t)row * DM + (lane + 64 * i) * 8); }
        float s = 0.f;
#pragma unroll
        for (int i = 0; i < 4; ++i)
#pragma unroll
            for (int k = 0; k < 4; ++k) { v[8 * i + 2 * k] = bf_lo(zv[i][k]) + ALPHA * bf_lo(xv[i][k]); v[8 * i + 2 * k + 1] = bf_hi(zv[i][k]) + ALPHA * bf_hi(xv[i][k]); s += v[8 * i + 2 * k] + v[8 * i + 2 * k + 1]; }
        s = wave_sum(s); const float mu = s * (1.0f / 2048.0f); float q = 0.f;
#pragma unroll
        for (int k = 0; k < 32; ++k) { const float d = v[k] - mu; q += d * d; }
        q = wave_sum(q); const float rstd = rsqrtf(q * (1.0f / 2048.0f) + 1e-5f);
#pragma unroll
        for (int i = 0; i < 4; ++i) {
            const int c0 = (lane + 64 * i) * 8;
            const f32x4 ga = *(const f32x4*)(g + c0), gb = *(const f32x4*)(g + c0 + 4), ba = *(const f32x4*)(b + c0), bb = *(const f32x4*)(b + c0 + 4);
            u32x4 o;
            o.x = pk2((v[8 * i + 0] - mu) * rstd * ga[0] + ba[0], (v[8 * i + 1] - mu) * rstd * ga[1] + ba[1]);
            o.y = pk2((v[8 * i + 2] - mu) * rstd * ga[2] + ba[2], (v[8 * i + 3] - mu) * rstd * ga[3] + ba[3]);
            o.z = pk2((v[8 * i + 4] - mu) * rstd * gb[0] + bb[0], (v[8 * i + 5] - mu) * rstd * gb[1] + bb[1]);
            o.w = pk2((v[8 * i + 6] - mu) * rstd * gb[2] + bb[2], (v[8 * i + 7] - mu) * rstd * gb[3] + bb[3]);
            *(u32x4*)(H + (size_t)row * DM + c0) = o;
        }
    }
}


DI void table_fp4_phase(const float* __restrict__ src, unsigned char* __restrict__ dst, float* __restrict__ scale, int bid, int nb) {
    const int lane = threadIdx.x & 63, w = threadIdx.x >> 6;
    for (int row = bid * 8 + w; row < 16384; row += nb * 8) {
        f32x4 v[8]; float am = 0.f;
#pragma unroll
        for (int k = 0; k < 8; ++k) { v[k] = *(const f32x4*)(src + (size_t)row * DM + lane * 32 + 4 * k);
            am = fmaxf(am, fmaxf(fmaxf(fabsf(v[k][0]), fabsf(v[k][1])), fmaxf(fabsf(v[k][2]), fabsf(v[k][3])))); }
        am = fmaxf(am, __shfl_xor(am, 1)); am = fmaxf(am, __shfl_xor(am, 2)); am = fmaxf(am, __shfl_xor(am, 4)); am = fmaxf(am, __shfl_xor(am, 8)); am = fmaxf(am, __shfl_xor(am, 16)); am = fmaxf(am, __shfl_xor(am, 32));
        const float sc = am > 0.f ? am * (0.8f / 6.0f) : 1.0f, inv = 1.0f / sc;
        if (lane == 0) scale[row] = sc;
        u32x4 o;
#pragma unroll
        for (int k = 0; k < 4; ++k) {
            unsigned wd = 0;
            wd = __builtin_amdgcn_cvt_scalef32_pk_fp4_f32(wd, v[2 * k][0] * inv, v[2 * k][1] * inv, 1.0f, 0);
            wd = __builtin_amdgcn_cvt_scalef32_pk_fp4_f32(wd, v[2 * k][2] * inv, v[2 * k][3] * inv, 1.0f, 1);
            wd = __builtin_amdgcn_cvt_scalef32_pk_fp4_f32(wd, v[2 * k + 1][0] * inv, v[2 * k + 1][1] * inv, 1.0f, 2);
            wd = __builtin_amdgcn_cvt_scalef32_pk_fp4_f32(wd, v[2 * k + 1][2] * inv, v[2 * k + 1][3] * inv, 1.0f, 3);
            o[k] = wd;
        }
        *(u32x4*)(dst + ((size_t)(lane >> 3) * 16384 + row) * 128 + (lane & 7) * 16) = o;
    }
}

#define INS16(r, x) { _Pragma("unroll") for (int j_ = 15; j_ >= 1; --j_) r[j_] = __builtin_amdgcn_fmed3f(r[j_ - 1], r[j_], x); r[0] = fmaxf(r[0], x); }
DI float gelu_f(float x) { return 0.5f * x * (1.0f + erff(x * 0.7071067811865476f)); }


DI void route_phase(const float* __restrict__ scores, int* __restrict__ sel_eid, float* __restrict__ sel_gate, unsigned char* lds, int bid, int nb) {
    const int full = nb * 512 < TOK * 8 ? nb * 512 : TOK * 8, rest = TOK * 8 - full;
    int pb = rest > 0 ? (rest + nb - 1) / nb : 0; if (pb > 512) pb = 512;
    for (int seg = 0; seg < 2; ++seg)
    for (int row = seg == 0 ? bid * 512 + (int)threadIdx.x : ((int)threadIdx.x < pb ? full + bid * pb + (int)threadIdx.x : TOK * 8); row < (seg == 0 ? full : TOK * 8); row += (seg == 0 ? nb * 512 : nb * pb)) {
        const size_t tok = (size_t)(row >> 3); const int head = row & 7;
        const float4* sp = (const float4*)(scores + tok * DM + head * 256);
        float r1[16], r2[16];
#pragma unroll
        for (int j = 0; j < 16; ++j) { r1[j] = -INFINITY; r2[j] = -INFINITY; }
#define RT_INS(R, V, IDX) { const float x_ = __uint_as_float((__float_as_uint(V) & 0xffffff80u) | (unsigned)(IDX)); INS16(R, x_) }
        for (int i8 = 0; i8 < 4; ++i8) {
            float4 a[8];
#pragma unroll
            for (int q = 0; q < 8; ++q) a[q] = sp[8 * i8 + q];
#pragma unroll
            for (int q = 0; q < 8; ++q) { const int b4 = 4 * (8 * i8 + q); RT_INS(r1, a[q].x, b4) RT_INS(r1, a[q].y, b4 + 1) RT_INS(r1, a[q].z, b4 + 2) RT_INS(r1, a[q].w, b4 + 3) }
        }
        for (int i8 = 0; i8 < 4; ++i8) {
            float4 a[8];
#pragma unroll
            for (int q = 0; q < 8; ++q) a[q] = sp[32 + 8 * i8 + q];
#pragma unroll
            for (int q = 0; q < 8; ++q) { const int b4 = 4 * (8 * i8 + q); RT_INS(r2, a[q].x, b4) RT_INS(r2, a[q].y, b4 + 1) RT_INS(r2, a[q].z, b4 + 2) RT_INS(r2, a[q].w, b4 + 3) }
        }
#undef RT_INS
        unsigned* sidx = (unsigned*)lds;
#pragma unroll
        for (int d = 0; d < 4; ++d) {
            sidx[d * 512 + threadIdx.x] = (__float_as_uint(r1[4 * d]) & 127u) | ((__float_as_uint(r1[4 * d + 1]) & 127u) << 8) | ((__float_as_uint(r1[4 * d + 2]) & 127u) << 16) | ((__float_as_uint(r1[4 * d + 3]) & 127u) << 24);
            sidx[(4 + d) * 512 + threadIdx.x] = (__float_as_uint(r2[4 * d]) & 127u) | ((__float_as_uint(r2[4 * d + 1]) & 127u) << 8) | ((__float_as_uint(r2[4 * d + 2]) & 127u) << 16) | ((__float_as_uint(r2[4 * d + 3]) & 127u) << 24);
        }
        float bk[16];
#pragma unroll
        for (int j = 0; j < 16; ++j) bk[j] = -INFINITY;
#pragma unroll
        for (int a = 0; a < 16; ++a)
#pragma unroll
            for (int b = 0; b < 16; ++b)
                if ((a + 1) * (b + 1) <= 16) {
                    const float ksum = __uint_as_float(__float_as_uint(r1[a]) & 0xffffff80u) + __uint_as_float(__float_as_uint(r2[b]) & 0xffffff80u);
                    const float key = __uint_as_float((__float_as_uint(ksum) & 0xffffff00u) | (unsigned)(a * 16 + b));
                    INS16(bk, key)
                }
        int bpay[16];
#pragma unroll
        for (int j = 0; j < 16; ++j) {
            const unsigned pos = __float_as_uint(bk[j]) & 255u, pa = pos >> 4, pb = pos & 15u;
            const unsigned i1 = (sidx[(pa >> 2) * 512 + threadIdx.x] >> (8 * (pa & 3))) & 127u, i2 = (sidx[(4 + (pb >> 2)) * 512 + threadIdx.x] >> (8 * (pb & 3))) & 127u;
            bpay[j] = (int)((i1 << 7) | i2);
        }
        float ex[16], ssum = 0.f;
#pragma unroll
        for (int j = 0; j < 16; ++j) { ex[j] = __expf(bk[j] - bk[0]); ssum += ex[j]; }
        const float inv = 1.0f / ssum;
        int* ed = sel_eid + tok * 128 + head * 16; float* gd = sel_gate + tok * 128 + head * 16;
#pragma unroll
        for (int j4 = 0; j4 < 4; ++j4) {
            *(int4*)(ed + 4 * j4) = make_int4(bpay[4 * j4], bpay[4 * j4 + 1], bpay[4 * j4 + 2], bpay[4 * j4 + 3]);
            *(float4*)(gd + 4 * j4) = make_float4(ex[4 * j4] * inv, ex[4 * j4 + 1] * inv, ex[4 * j4 + 2] * inv, ex[4 * j4 + 3] * inv);
        }
    }
}

template <int CTRL> DI float dpp_f(float x) { return __int_as_float(__builtin_amdgcn_update_dpp(0, __float_as_int(x), CTRL, 0xf, 0xf, false)); }
DI float sum8(float x) { x += dpp_f<0xB1>(x); x += dpp_f<0x4E>(x); x += dpp_f<0x141>(x); return x; }
#define FP4PAIR(wd, b) __builtin_amdgcn_cvt_scalef32_pk_f32_fp4((wd), 1.0f, (b))
DI void peerA_step(u32x4 (&cur)[16], u32x4 (&nxt)[16], const u32x4 (&hcur)[4], u32x4 (&hnxt)[4], int (&eidN)[16], const unsigned char* Ubase, unsigned loff,
                   const bf16_t* hn_ptr, const int* epnn, float* pp, bool do_store, int g, int j) {
#pragma unroll
    for (int i = 0; i < 16; ++i) nxt[i] = *(const u32x4*)(Ubase + (((unsigned)eidN[i] << 7) + loff));
#pragma unroll
    for (int k = 0; k < 4; ++k) hnxt[k] = __builtin_nontemporal_load((const u32x4*)(hn_ptr + 8 * k));
#pragma unroll
    for (int i = 0; i < 16; ++i) eidN[i] = __builtin_nontemporal_load(epnn + 8 * i);
    unsigned hw[16];
#pragma unroll
    for (int k = 0; k < 4; ++k) { hw[4 * k] = hcur[k].x; hw[4 * k + 1] = hcur[k].y; hw[4 * k + 2] = hcur[k].z; hw[4 * k + 3] = hcur[k].w; }
#pragma unroll
    for (int q = 0; q < 16; ++q) asm volatile("" : "+v"(hw[q]));
    float part[16];
#pragma unroll
    for (int i = 0; i < 16; ++i) {
        float a = 0.f;
#pragma unroll
        for (int k = 0; k < 4; ++k) {
            a = __builtin_amdgcn_fdot2_f32_bf16(__builtin_amdgcn_cvt_scalef32_pk_bf16_fp4(cur[i][k], 1.0f, 0), __builtin_bit_cast(bf16x2_t, hw[4 * k + 0]), a, false);
            a = __builtin_amdgcn_fdot2_f32_bf16(__builtin_amdgcn_cvt_scalef32_pk_bf16_fp4(cur[i][k], 1.0f, 1), __builtin_bit_cast(bf16x2_t, hw[4 * k + 1]), a, false);
            a = __builtin_amdgcn_fdot2_f32_bf16(__builtin_amdgcn_cvt_scalef32_pk_bf16_fp4(cur[i][k], 1.0f, 2), __builtin_bit_cast(bf16x2_t, hw[4 * k + 2]), a, false);
            a = __builtin_amdgcn_fdot2_f32_bf16(__builtin_amdgcn_cvt_scalef32_pk_bf16_fp4(cur[i][k], 1.0f, 3), __builtin_bit_cast(bf16x2_t, hw[4 * k + 3]), a, false);
        }
        part[i] = a;
    }
    const bool b0 = (j & 1) != 0, b1 = (j & 2) != 0, b2 = (j & 4) != 0;
    float r8[8], r4[4], r2[2];
#pragma unroll
    for (int k = 0; k < 8; ++k) { const float keep = b0 ? part[8 + k] : part[k], send = b0 ? part[k] : part[8 + k]; r8[k] = keep + dpp_f<0xB1>(send); }
#pragma unroll
    for (int k = 0; k < 4; ++k) { const float keep = b1 ? r8[4 + k] : r8[k], send = b1 ? r8[k] : r8[4 + k]; r4[k] = keep + dpp_f<0x4E>(send); }
#pragma unroll
    for (int k = 0; k < 2; ++k) { const float keep = b2 ? r4[2 + k] : r4[k], send = b2 ? r4[k] : r4[2 + k]; r2[k] = keep + dpp_f<0x1B>(dpp_f<0x141>(send)); }
    const int i0 = (b0 ? 8 : 0) + (b1 ? 4 : 0) + (b2 ? 2 : 0);
    if (do_store) { __builtin_nontemporal_store(r2[0], pp + 8 * i0 + g); __builtin_nontemporal_store(r2[1], pp + 8 * i0 + 8 + g); }
}
DI void peerA_phase(const bf16_t* __restrict__ H, const unsigned char* __restrict__ U4, const int* __restrict__ sel_eid, float* __restrict__ P, int bid, int nb) {
    const int lane = threadIdx.x & 63, w = threadIdx.x >> 6, g = lane >> 3, j = lane & 7;
    const int s = bid & 7, nxb = nb >> 3;
    if ((bid >> 3) >= nxb) return;
    const int widx = (bid >> 3) * 8 + w, nw = nxb * 8;
    const int ntok = (TOK - widx + nw - 1) / nw;
    const size_t coff = (size_t)(256 * s + 32 * j); const unsigned char* Ubase = U4 + (size_t)s * (16384 * 128); const unsigned loff = 16u * j;
    int eidN[16]; u32x4 uvA[16], uvB[16]; u32x4 hA[4], hB[4];
    {   const int t0 = widx, t1 = ntok > 1 ? widx + nw : widx;
        const int* ep = sel_eid + (size_t)t0 * 128 + g;
#pragma unroll
        for (int i = 0; i < 16; ++i) eidN[i] = __builtin_nontemporal_load(ep + 8 * i);
#pragma unroll
        for (int k = 0; k < 4; ++k) hA[k] = __builtin_nontemporal_load((const u32x4*)(H + (size_t)t0 * DM + coff + 8 * k));
#pragma unroll
        for (int i = 0; i < 16; ++i) uvA[i] = *(const u32x4*)(Ubase + (((unsigned)eidN[i] << 7) + loff));
        ep = sel_eid + (size_t)t1 * 128 + g;
#pragma unroll
        for (int i = 0; i < 16; ++i) eidN[i] = __builtin_nontemporal_load(ep + 8 * i);
    }
#define TOKC(x) (widx + ((x) < ntok ? (x) : ntok - 1) * nw)
    for (int it = 0; it < ntok; it += 2) {
        {   const int t = TOKC(it), tn = TOKC(it + 1), tnn = TOKC(it + 2);
            peerA_step(uvA, uvB, hA, hB, eidN, Ubase, loff, H + (size_t)tn * DM + coff, sel_eid + (size_t)tnn * 128 + g, P + ((size_t)t * 8 + s) * 128, true, g, j); }
        {   const int t = TOKC(it + 1), tn = TOKC(it + 2), tnn = TOKC(it + 3);
            peerA_step(uvB, uvA, hB, hA, eidN, Ubase, loff, H + (size_t)tn * DM + coff, sel_eid + (size_t)tnn * 128 + g, P + ((size_t)t * 8 + s) * 128, it + 1 < ntok, g, j); }
    }
}
DI void peerC_phase(const float* __restrict__ P, const int* __restrict__ sel_eid, const float* __restrict__ sel_gate, const float* __restrict__ Us, const float* __restrict__ Vs, float* __restrict__ C, int bid, int nb) {
    const int lane = threadIdx.x & 63, w = threadIdx.x >> 6;
    for (int t = bid * 8 + w; t < TOK; t += nb * 8) {
        const float* pp = P + (size_t)t * 1024;
        float d0 = 0.f, d1 = 0.f;
#pragma unroll
        for (int s = 0; s < 8; ++s) { d0 += pp[s * 128 + lane]; d1 += pp[s * 128 + 64 + lane]; }
        const int e0 = sel_eid[(size_t)t * 128 + lane], e1 = sel_eid[(size_t)t * 128 + 64 + lane];
        C[(size_t)t * 128 + lane] = sel_gate[(size_t)t * 128 + lane] * Vs[e0] * gelu_f(d0 * Us[e0]);
        C[(size_t)t * 128 + 64 + lane] = sel_gate[(size_t)t * 128 + 64 + lane] * Vs[e1] * gelu_f(d1 * Us[e1]);
    }
}
DI void peerB_step(u32x4 (&cur)[16], u32x4 (&nxt)[16], const float (&cfcur)[16], float (&cfnxt)[16], int (&eidN)[16], const unsigned char* Vbase, unsigned loff,
                   const float* cpn, const int* epnn, bf16_t* op, bool do_store, bool b3) {
#pragma unroll
    for (int i = 0; i < 16; ++i) nxt[i] = *(const u32x4*)(Vbase + (((unsigned)eidN[i] << 7) + loff));
#pragma unroll
    for (int i = 0; i < 16; ++i) { eidN[i] = __builtin_nontemporal_load(epnn + 8 * i); cfnxt[i] = __builtin_nontemporal_load(cpn + 8 * i); }
    f32x2_t o[16];
#pragma unroll
    for (int k = 0; k < 16; ++k) o[k] = (f32x2_t){0.f, 0.f};
#pragma unroll
    for (int i = 0; i < 16; ++i) {
        const f32x2_t c2 = {cfcur[i], cfcur[i]};
#pragma unroll
        for (int k = 0; k < 4; ++k) {
            o[4 * k + 0] = FP4PAIR(cur[i][k], 0) * c2 + o[4 * k + 0]; o[4 * k + 1] = FP4PAIR(cur[i][k], 1) * c2 + o[4 * k + 1];
            o[4 * k + 2] = FP4PAIR(cur[i][k], 2) * c2 + o[4 * k + 2]; o[4 * k + 3] = FP4PAIR(cur[i][k], 3) * c2 + o[4 * k + 3];
        }
    }
    f32x2_t q8[8];
#pragma unroll
    for (int k = 0; k < 8; ++k) {
        const u32x2 sx = __builtin_amdgcn_permlane32_swap(__float_as_uint(o[k].x), __float_as_uint(o[8 + k].x), false, false);
        const u32x2 sy = __builtin_amdgcn_permlane32_swap(__float_as_uint(o[k].y), __float_as_uint(o[8 + k].y), false, false);
        q8[k] = (f32x2_t){__uint_as_float(sx.x) + __uint_as_float(sx.y), __uint_as_float(sy.x) + __uint_as_float(sy.y)};
    }
    f32x2_t q4[4];
#pragma unroll
    for (int k = 0; k < 4; ++k) {
        const u32x2 sx = __builtin_amdgcn_permlane16_swap(__float_as_uint(q8[k].x), __float_as_uint(q8[4 + k].x), false, false);
        const u32x2 sy = __builtin_amdgcn_permlane16_swap(__float_as_uint(q8[k].y), __float_as_uint(q8[4 + k].y), false, false);
        q4[k] = (f32x2_t){__uint_as_float(sx.x) + __uint_as_float(sx.y), __uint_as_float(sy.x) + __uint_as_float(sy.y)};
    }
    f32x4 fin;
#pragma unroll
    for (int k = 0; k < 2; ++k) {
        const f32x2_t keep = b3 ? q4[2 + k] : q4[k], send = b3 ? q4[k] : q4[2 + k];
        fin[2 * k] = keep.x + dpp_f<0x128>(send.x); fin[2 * k + 1] = keep.y + dpp_f<0x128>(send.y);
    }
    if (do_store) { u32x2 fo; fo.x = pk2(fin[0], fin[1]); fo.y = pk2(fin[2], fin[3]); __builtin_nontemporal_store(fo, (u32x2*)op); }
}
DI void peerB_phase(const unsigned char* __restrict__ V4, const int* __restrict__ sel_eid, const float* __restrict__ C, float* __restrict__ outpre, int bid, int nb) {
    const int lane = threadIdx.x & 63, w = threadIdx.x >> 6, g = lane >> 3, j = lane & 7;
    const int s = bid & 7, nxb = nb >> 3;
    if ((bid >> 3) >= nxb) return;
    const int widx = (bid >> 3) * 8 + w, nw = nxb * 8;
    const int ntok = (TOK - widx + nw - 1) / nw;
    const bool b5 = (lane & 32) != 0, b4 = (lane & 16) != 0, b3 = (lane & 8) != 0;
    const int qidx = (b5 ? 4 : 0) + (b4 ? 2 : 0) + (b3 ? 1 : 0);
    const size_t coff = (size_t)(256 * s + 32 * j) + 4 * qidx; const unsigned char* Vbase = V4 + (size_t)s * (16384 * 128); const unsigned loff = 16u * j;
    int eidN[16]; float cfA[16], cfB[16]; u32x4 vvA[16], vvB[16];
    {   const int t0 = widx, t1 = ntok > 1 ? widx + nw : widx;
        const int* ep = sel_eid + (size_t)t0 * 128 + g; const float* cp = C + (size_t)t0 * 128 + g;
#pragma unroll
        for (int i = 0; i < 16; ++i) { eidN[i] = __builtin_nontemporal_load(ep + 8 * i); cfA[i] = __builtin_nontemporal_load(cp + 8 * i); }
#pragma unroll
        for (int i = 0; i < 16; ++i) vvA[i] = *(const u32x4*)(Vbase + (((unsigned)eidN[i] << 7) + loff));
        ep = sel_eid + (size_t)t1 * 128 + g;
#pragma unroll
        for (int i = 0; i < 16; ++i) eidN[i] = __builtin_nontemporal_load(ep + 8 * i);
    }
    for (int it = 0; it < ntok; it += 2) {
        {   const int t = TOKC(it), tn = TOKC(it + 1), tnn = TOKC(it + 2);
            peerB_step(vvA, vvB, cfA, cfB, eidN, Vbase, loff, C + (size_t)tn * 128 + g, sel_eid + (size_t)tnn * 128 + g, (bf16_t*)(outpre + (size_t)t * DM) + coff, true, b3); }
        {   const int t = TOKC(it + 1), tn = TOKC(it + 2), tnn = TOKC(it + 3);
            peerB_step(vvB, vvA, cfB, cfA, eidN, Vbase, loff, C + (size_t)tn * 128 + g, sel_eid + (size_t)tnn * 128 + g, (bf16_t*)(outpre + (size_t)t * DM) + coff, it + 1 < ntok, b3); }
    }
#undef TOKC
}
DI void ln2_phase(const bf16_t* __restrict__ H, float* io, const float* __restrict__ g, const float* __restrict__ b, int bid, int nb) {
    const int lane = threadIdx.x & 63, w = threadIdx.x >> 6;
    for (int t = bid * 8 + w; t < TOK; t += nb * 8) {
        float v[32]; float s = 0.f;
#pragma unroll
        for (int i = 0; i < 4; ++i) {
            const int c0 = (lane + 64 * i) * 8;
            const u32x4 hv = *(const u32x4*)(H + (size_t)t * DM + c0);
            const u32x4 ov = *(const u32x4*)((const bf16_t*)(io + (size_t)t * DM) + c0);
            const f32x4 a = {bf_lo(ov.x), bf_hi(ov.x), bf_lo(ov.y), bf_hi(ov.y)}, c = {bf_lo(ov.z), bf_hi(ov.z), bf_lo(ov.w), bf_hi(ov.w)};
            v[8 * i + 0] = a[0] + ALPHA * bf_lo(hv[0]); v[8 * i + 1] = a[1] + ALPHA * bf_hi(hv[0]); v[8 * i + 2] = a[2] + ALPHA * bf_lo(hv[1]); v[8 * i + 3] = a[3] + ALPHA * bf_hi(hv[1]);
            v[8 * i + 4] = c[0] + ALPHA * bf_lo(hv[2]); v[8 * i + 5] = c[1] + ALPHA * bf_hi(hv[2]); v[8 * i + 6] = c[2] + ALPHA * bf_lo(hv[3]); v[8 * i + 7] = c[3] + ALPHA * bf_hi(hv[3]);
#pragma unroll
            for (int k = 0; k < 8; ++k) s += v[8 * i + k];
        }
        s = wave_sum(s); const float mu = s * (1.0f / 2048.0f); float q = 0.f;
#pragma unroll
        for (int k = 0; k < 32; ++k) { const float d = v[k] - mu; q += d * d; }
        q = wave_sum(q); const float rstd = rsqrtf(q * (1.0f / 2048.0f) + 1e-5f);
#pragma unroll
        for (int i = 0; i < 4; ++i) {
            const int c0 = (lane + 64 * i) * 8;
            const f32x4 ga = *(const f32x4*)(g + c0), gb = *(const f32x4*)(g + c0 + 4), ba = *(const f32x4*)(b + c0), bb = *(const f32x4*)(b + c0 + 4);
            f32x4 y0, y1;
#pragma unroll
            for (int k = 0; k < 4; ++k) { y0[k] = (v[8 * i + k] - mu) * rstd * ga[k] + ba[k]; y1[k] = (v[8 * i + 4 + k] - mu) * rstd * gb[k] + bb[k]; }
            *(f32x4*)(io + (size_t)t * DM + c0) = y0; *(f32x4*)(io + (size_t)t * DM + c0 + 4) = y1;
        }
    }
}

#define XB_TMO      128
#define XB_XCNT(j)  (256  + 64 * (j))
#define XB_XSUB(j)  (1280 + 64 * (j))
#define XB_XGEN(j)  (2304 + 64 * (j))
#define XB_TOP      3328
#define XB_TOPGEN   3392
#define XCD_BAR_WORDS 3456
#define XB_SPIN_CAP (1u << 18)
#define LAS __attribute__((address_space(3)))

__device__ __forceinline__ unsigned xb_ld(unsigned* p)              { return __hip_atomic_load(p, __ATOMIC_RELAXED, __HIP_MEMORY_SCOPE_AGENT); }
__device__ __forceinline__ unsigned xb_add(unsigned* p, unsigned v) { return __hip_atomic_fetch_add(p, v, __ATOMIC_RELAXED, __HIP_MEMORY_SCOPE_AGENT); }
__device__ __forceinline__ unsigned xb_xcc_id() { return (unsigned)__builtin_amdgcn_s_getreg((3 << 11) | 20) & 0xFu; }
#define XB_SPIN(cond, bar) do { unsigned _sp = 0; while (cond) { __builtin_amdgcn_s_sleep(1); \
    if ((++_sp & 255u) == 0u) { if (xb_ld(&(bar)[XB_TMO])) break; if (_sp > XB_SPIN_CAP) { atomicAdd(&(bar)[XB_TMO], 1u); break; } } } } while (0)

struct XcdBarrier {
    unsigned* bar; unsigned x;
    volatile LAS unsigned* st;
};

__device__ __forceinline__ XcdBarrier xcd_barrier_post(unsigned* bar, volatile LAS unsigned* st) {
    XcdBarrier b; b.bar = bar; b.x = xb_xcc_id(); b.st = st;
    if (threadIdx.x == 0) (void)xb_add(&bar[XB_XCNT(b.x)], 1u);
    return b;
}
__device__ __forceinline__ void xcd_barrier_complete(unsigned* bar, unsigned x, unsigned& nloc, unsigned& nx) {
    const unsigned G = gridDim.x * gridDim.y * gridDim.z;
    unsigned sum, cnt, mine, sp = 0u;
    for (;;) {
        sum = 0u; cnt = 0u; mine = 0u;
#pragma unroll
        for (unsigned j = 0; j < 16; ++j) { const unsigned c = xb_ld(&bar[XB_XCNT(j)]); sum += c; cnt += (c > 0u) ? 1u : 0u; mine = (j == x) ? c : mine; }
        if (sum == G) break;
        __builtin_amdgcn_s_sleep(1);
        if ((++sp & 255u) == 0u) { if (xb_ld(&bar[XB_TMO])) break; if (sp > XB_SPIN_CAP) { atomicAdd(&bar[XB_TMO], 1u); break; } }
    }
    nloc = mine > 0u ? mine : 1u; nx = cnt > 0u ? cnt : 1u;
}

__device__ __forceinline__ void xcd_barrier(const XcdBarrier& b) {
    asm volatile("s_waitcnt vmcnt(0)" ::: "memory");
    __syncthreads();
    if (threadIdx.x == 0) {
        unsigned* bar = b.bar;
        __builtin_amdgcn_s_waitcnt(0);
        unsigned nloc = b.st[0], nx = b.st[1];
        if (nloc == 0u) { xcd_barrier_complete(bar, b.x, nloc, nx); b.st[0] = nloc; b.st[1] = nx; }
        const unsigned old = xb_add(&bar[XB_XSUB(b.x)], 1u);
        const unsigned gen = old / nloc;
        if (old + 1u == (gen + 1u) * nloc) {
            __builtin_amdgcn_fence(__ATOMIC_RELEASE, "agent");
            asm volatile("s_waitcnt vmcnt(0)" ::: "memory");
            const unsigned og = xb_add(&bar[XB_TOP], 1u);
            const unsigned tg = og / nx;
            if (og + 1u == (tg + 1u) * nx) xb_add(&bar[XB_TOPGEN], 1u);
            else XB_SPIN(xb_ld(&bar[XB_TOPGEN]) == tg, bar);
            __builtin_amdgcn_fence(__ATOMIC_ACQUIRE, "agent");
            xb_add(&bar[XB_XGEN(b.x)], 1u);
            asm volatile("s_waitcnt vmcnt(0)" ::: "memory");
        } else {
            XB_SPIN(xb_ld(&bar[XB_XGEN(b.x)]) == gen, bar);
            __builtin_amdgcn_fence(__ATOMIC_ACQUIRE, "agent");
            asm volatile("s_waitcnt vmcnt(0)" ::: "memory");
        }
    }
    __syncthreads();
}

__global__ void __launch_bounds__(512) hymba_fwd(Params p) {
    extern __shared__ __attribute__((aligned(16))) unsigned char lds[];
    cg::grid_group grid = cg::this_grid();
    volatile LAS unsigned* bst = (volatile LAS unsigned*)(lds + 131072);
    if (threadIdx.x < 2) bst[threadIdx.x] = 0u;
    __syncthreads();
    const XcdBarrier xbar = xcd_barrier_post((unsigned*)(p.ws + WS_END + 131072), bst);
    const int bid = blockIdx.x, nb = gridDim.x;
    unsigned char* ws = p.ws;
    bf16_t* xb = (bf16_t*)(ws + WS_R0); bf16_t* mix = (bf16_t*)(ws + WS_R2);
    unsigned char* U8 = ws + WS_R0 + 96 * MiB; unsigned char* V8 = ws + WS_R0 + 112 * MiB; float* Us = (float*)(ws + WS_END); float* Vs = Us + 16384;
    bf16_t* Uc = (bf16_t*)(ws + WS_R1); bf16_t* BG = (bf16_t*)(ws + WS_R1 + 48 * MiB); bf16_t* Z = (bf16_t*)(ws + WS_R1);
    bf16_t* KVf = (bf16_t*)(ws + WS_R2); bf16_t* KVb = (bf16_t*)(ws + WS_R2 + 48 * MiB); bf16_t* H = (bf16_t*)(ws + WS_R2);
    bf16_t* Sf = (bf16_t*)(ws + WS_R3); bf16_t* Sb = (bf16_t*)(ws + WS_R3 + 48 * MiB);
    bf16_t* WinT = (bf16_t*)(ws + WS_W); bf16_t* WoutT = (bf16_t*)(ws + WS_W + 28 * MiB); bf16_t* WqkT = (bf16_t*)(ws + WS_W + 36 * MiB);
    bf16_t* Q = (bf16_t*)p.out; bf16_t* K = Q + (size_t)TOK * RW; bf16_t* V = K + (size_t)TOK * RW; bf16_t* G = V + (size_t)TOK * RW;

#ifndef PH_MASK
#define PH_MASK 0xFFFF
#endif
    if (PH_MASK & 1) {
    convert_flat(p.x_prompt, xb, (size_t)8192 * DM / 8, bid, nb);
    convert_flat(p.x_sample, xb + (size_t)8192 * DM, (size_t)16384 * DM / 8, bid, nb);
    transpose_convert<true>(p.w_in, NPROJ, WinT, NPROJ, bid, nb);
    transpose_convert<false>(p.w_out, DM, WoutT, DM, bid, nb);
    fold_phase(p.w_query, p.keys1, p.keys2, WqkT, lds, bid, nb);
    }
    if (p.ws == nullptr) grid.sync();
    xcd_barrier(xbar);
    if (PH_MASK & 2) {
        pg8::Gemm g{xb, WinT, TOK, NPROJ, DM}; pg8::StaticOrder S; S.init(TOK, NPROJ, nb, bid);
        EpiInProj E{Q, Uc, BG};
        pg8::gemm_phase<EpiInProj, pg8::StaticOrder, false>((PG8_LAS unsigned char*)lds, g, S, E, nullptr);
        const int rem = ((TOK / 256) * (NPROJ / 256)) % nb;
        if (rem) { if (bid >= rem) table_fp4_phase(p.peer_u, U8, Us, bid - rem, nb - rem); } else table_fp4_phase(p.peer_u, U8, Us, bid, nb);
    }
    xcd_barrier(xbar);
    if (PH_MASK & 4) r1_phase(K, V, KVf, KVb, p.rate_f, p.rate_b, lds, bid, nb);
    xcd_barrier(xbar);
    if (PH_MASK & 8) r2_phase(KVf, KVb, Sf, Sb, p.rate_f, p.rate_b, bid, nb);
    xcd_barrier(xbar);
    if (PH_MASK & 16) r3_phase(Q, K, V, G, Sf, Sb, p.rate_f, p.rate_b, p.gn_g, mix, lds, bid, nb);
    if (PH_MASK & 32) conv_phase(Uc, BG, p.conv_w, mix, bid, nb);
    xcd_barrier(xbar);
    if (PH_MASK & 64) {
        pg8::Gemm g{mix, WoutT, TOK, DM, DM}; pg8::StaticOrder S; S.init(TOK, DM, nb, bid);
        EpiOutProj E{Z};
        pg8::gemm_phase<EpiOutProj, pg8::StaticOrder, false>((PG8_LAS unsigned char*)lds, g, S, E, nullptr);
    }
    xcd_barrier(xbar);
    if (PH_MASK & 128) ln1_phase(Z, xb, p.ln1_g, p.ln1_b, H, bid, nb);
    table_fp4_phase(p.peer_v, V8, Vs, bid, nb);
    xcd_barrier(xbar);
    if (PH_MASK & 256) {
        pg8::Gemm g{H, WqkT, TOK, DM, DM}; pg8::StaticOrder S; S.init(TOK, DM, nb, bid);
        EpiScore E{p.out};
        pg8::gemm_phase<EpiScore, pg8::StaticOrder, false>((PG8_LAS unsigned char*)lds, g, S, E, nullptr);
    }
    xcd_barrier(xbar);
    {
        int* sel_eid = (int*)(ws + WS_R1); float* sel_gate = (float*)(ws + WS_R1 + 16 * MiB); float* Cf = (float*)(ws + WS_R1 + 32 * MiB);
        route_phase(p.out, sel_eid, sel_gate, lds, bid, nb);
        xcd_barrier(xbar);
        peerA_phase(H, U8, sel_eid, p.out, bid, nb);
        xcd_barrier(xbar);
        peerC_phase(p.out, sel_eid, sel_gate, Us, Vs, Cf, bid, nb);
        xcd_barrier(xbar);
        peerB_phase(V8, sel_eid, Cf, p.out, bid, nb);
        xcd_barrier(xbar);
        ln2_phase(H, p.out, p.ln2_g, p.ln2_b, bid, nb);
    }
}

extern "C" void kernel_launch(void* const* d_in, const int* in_sizes, int n_in, void* d_out, int out_size, void* d_ws, size_t ws_size, hipStream_t stream) {
    constexpr int LDS_BYTES = 131072 + 16;
    static int grid_blocks = 0;
    if (!grid_blocks) {
        int dev = 0, cus = 0, per_cu = 0;
        hipGetDevice(&dev);
        hipDeviceGetAttribute(&cus, hipDeviceAttributeMultiprocessorCount, dev);
        hipFuncSetAttribute((const void*)hymba_fwd, hipFuncAttributeMaxDynamicSharedMemorySize, LDS_BYTES);
        hipOccupancyMaxActiveBlocksPerMultiprocessor(&per_cu, (const void*)hymba_fwd, 512, LDS_BYTES);
        if (per_cu < 1) per_cu = 1;
        grid_blocks = cus * per_cu;
        if (ws_size < WS_END + 131072 + XCD_BAR_WORDS * 4) fprintf(stderr, "kernel_launch: workspace too small: %zu < %zu\n", ws_size, (size_t)WS_END);
    }
    (void)hipMemsetAsync((unsigned char*)d_ws + WS_END + 131072, 0, XCD_BAR_WORDS * 4, stream);
    Params p{};
    const float** pp = (const float**)&p;
    for (int i = 0; i < 17; ++i) pp[i] = (const float*)d_in[i];
    p.out = (float*)d_out; p.ws = (unsigned char*)d_ws;
    void* args[] = {&p};
    hipError_t e = hipLaunchCooperativeKernel((const void*)hymba_fwd, dim3(grid_blocks), dim3(512), args, LDS_BYTES, stream);
    if (e != hipSuccess) fprintf(stderr, "cooperative launch failed: %s (grid %d)\n", hipGetErrorString(e), grid_blocks);
}
```

```cpp
#include <hip/hip_runtime.h>
#include <hip/hip_cooperative_groups.h>
#include <cstdio>
namespace cg = cooperative_groups;
namespace pg8 {
#define PG8_LAS __attribute__((address_space(3)))
typedef unsigned short bf16_t;
typedef short bf16x8 __attribute__((ext_vector_type(8)));
typedef float f32x4 __attribute__((ext_vector_type(4)));
typedef unsigned u32x4 __attribute__((ext_vector_type(4)));
constexpr int BM = 256, BK = 64, HALF = 128, HTB = HALF * BK * 2  , STAGE_BYTES = 8 * HTB, NXCD = 8, WGM = 8;

__host__ __device__ __forceinline__ int lds_byte(int r, int c) { const int st = (r >> 4) * 2 + (c >> 5), rr = r & 15, cc = c & 31, ob = rr * 64 + cc * 2; return st * 1024 + (ob ^ (((ob >> 9) & 1) << 5)); }
__host__ __device__ __forceinline__ void stage_rc(int b, int& R, int& C) { const int st = b / 1024, sb = b % 1024, swz = sb ^ (((sb >> 9) & 1) << 5); R = (st >> 1) * 16 + swz / 64; C = (st & 1) * 32 + (swz % 64) / 2; }
__host__ __device__ __forceinline__ int perm32(int rho) { const int n = rho >> 4, i = rho & 15; return 8 * (i >> 2) + 4 * n + (i & 3); }

struct Unit { int pm, pn; };
struct Gemm { const bf16_t* A; const bf16_t* Bt; int M, N, K; };

struct StaticOrder {
    int nM, nN, nwg, G, c;
    __host__ __device__ void init(int M, int N, int G_, int c_) { nM = M / BM; nN = N / BM; nwg = nM * nN; G = G_; c = c_; }
    __host__ __device__ bool next(int i, Unit& u) const {
        const long L = (long)i * G + c; if (L >= nwg) return false;
        int wgid = (int)L; { const int q = nwg / NXCD, r = nwg % NXCD, xcd = wgid % NXCD, off = wgid / NXCD; wgid = (xcd < r ? xcd * (q + 1) : r * (q + 1) + (xcd - r) * q) + off; }
        const int nig = WGM * nN, gid = wgid / nig, fm = gid * WGM, gsz = (nM - fm) < WGM ? (nM - fm) : WGM;
        u.pm = fm + ((wgid % nig) % gsz); u.pn = (wgid % nig) / gsz; return true;
    }
    __device__ __forceinline__ void a_ready(const Unit&) const {}
    __device__ __forceinline__ void done(const Unit&) const {}
};
template <class Epi, class Sched, bool STAMP = false>
__device__ __forceinline__ void gemm_phase(PG8_LAS unsigned char* lds, const Gemm g, const Sched& S, const Epi& E, unsigned long long* stamps) {
    const int tid = threadIdx.x, wid = __builtin_amdgcn_readfirstlane(tid >> 6), lane = tid & 63, wr = wid >> 2, wc = wid & 3, fr = lane & 15, fq = lane >> 4;
    const int K = g.K, nt = K / BK;
    int ts_lo = 0, ts_hi = 0, nts = 0; const unsigned long long rt_entry = STAMP ? (unsigned long long)wall_clock64() : 0ull;
#define PG8_STAMP() do { if (STAMP && wid == 0 && nts < 64) { const unsigned long long _c = (unsigned long long)clock64(); \
        ts_lo = (lane == nts) ? (int)(unsigned)_c : ts_lo; ts_hi = (lane == nts) ? (int)(unsigned)(_c >> 32) : ts_hi; ++nts; } } while (0)
    PG8_STAMP();
    unsigned voffA[2], voffB[2];
#pragma unroll
    for (int i = 0; i < 2; ++i) { int R, C; stage_rc(tid * 16 + i * 8192, R, C); const int Rb = Epi::PERM ? ((R & ~31) + perm32(R & 31)) : R;
        voffA[i] = (unsigned)(R * K + C) * 2u; voffB[i] = (unsigned)(Rb * K + C) * 2u; }
    const size_t kstep = (size_t)(BK * 2);
    const size_t hstep = (size_t)HALF * K * 2;
    const size_t tstep = 2 * hstep;
    const unsigned ldsw = (unsigned)wid * 1024u;
    const int aoff = lds_byte(wr * 64 + fr, fq * 8), boff = lds_byte(wc * 32 + fr, fq * 8);
#define PG8_SA(b, h) (((b) * 2 + (h)) * HTB)
#define PG8_SB(b, h) ((4 + (b) * 2 + (h)) * HTB)
#define PG8_STAGE(bufoff, gbase, voff) do { _Pragma("unroll") for (int _i = 0; _i < 2; ++_i) \
        __builtin_amdgcn_global_load_lds((const unsigned*)((const char*)(gbase) + (voff)[_i]), (PG8_LAS unsigned*)(lds + (bufoff) + ldsw + _i * 8192), 16, 0, 0); } while (0)
#define PG8_LDA(dst, b, h) do { _Pragma("unroll") for (int m = 0; m < 4; ++m) _Pragma("unroll") for (int k = 0; k < 2; ++k) dst[m][k] = *(const PG8_LAS bf16x8*)(lds + PG8_SA(b, h) + aoff + m * 2048 + k * 1024); } while (0)
#define PG8_LDB(dst, b, h) do { _Pragma("unroll") for (int n = 0; n < 2; ++n) _Pragma("unroll") for (int k = 0; k < 2; ++k) dst[n][k] = *(const PG8_LAS bf16x8*)(lds + PG8_SB(b, h) + boff + n * 2048 + k * 1024); } while (0)
#define PG8_MMA(ai, bj, At, Bt) do { __builtin_amdgcn_s_setprio(1); _Pragma("unroll") for (int m = 0; m < 4; ++m) _Pragma("unroll") for (int n = 0; n < 2; ++n) _Pragma("unroll") for (int k = 0; k < 2; ++k) \
        acc[ai][bj][m][n] = __builtin_amdgcn_mfma_f32_16x16x32_bf16(Bt[n][k], At[m][k], acc[ai][bj][m][n], 0, 0, 0); __builtin_amdgcn_s_setprio(0); } while (0)
#define PG8_WAIT_V(n) asm volatile("s_waitcnt vmcnt(" #n ")" ::: "memory")
#define PG8_WAIT_L(n) asm volatile("s_waitcnt lgkmcnt(" #n ")" ::: "memory")
#define PG8_BAR __builtin_amdgcn_s_barrier()
#define PG8_SCHED __builtin_amdgcn_sched_barrier(0)
    Unit cur, nxt; int ui = 0;
    if (!S.next(0, cur)) return;
    f32x4 acc[2][2][4][2];
#pragma unroll
    for (int a = 0; a < 2; ++a)
#pragma unroll
        for (int b = 0; b < 2; ++b)
#pragma unroll
            for (int m = 0; m < 4; ++m)
#pragma unroll
                for (int n = 0; n < 2; ++n) acc[a][b][m][n] = (f32x4){0.f, 0.f, 0.f, 0.f};
    bf16x8 At[4][2], B0[2][2], B1[2][2];
    const char* cA = (const char*)g.A + (size_t)cur.pm * tstep; const char* cB = (const char*)g.Bt + (size_t)cur.pn * tstep;
    S.a_ready(cur);
    PG8_STAGE(PG8_SB(0, 0), cB, voffB); PG8_STAGE(PG8_SA(0, 0), cA, voffA); PG8_STAGE(PG8_SB(0, 1), cB + hstep, voffB); PG8_STAGE(PG8_SA(0, 1), cA + hstep, voffA);
    if (wr == 1) PG8_BAR;
    PG8_WAIT_V(4); PG8_BAR;
    PG8_STAGE(PG8_SB(1, 0), cB + kstep, voffB); PG8_STAGE(PG8_SA(1, 0), cA + kstep, voffA); PG8_STAGE(PG8_SB(1, 1), cB + hstep + kstep, voffB);
    PG8_WAIT_V(6); PG8_BAR;
    PG8_STAMP();
    for (;;) {
        const bool has_next = S.next(ui + 1, nxt);
        const char* nA = has_next ? (const char*)g.A + (size_t)nxt.pm * tstep : cA; const char* nB = has_next ? (const char*)g.Bt + (size_t)nxt.pn * tstep : cB;
        for (int t = 0; t < nt; t += 2) {
            const bool last = (t == nt - 2);
            const char* a1 = cA + (size_t)(t + 1) * kstep;
            const char* a2 = last ? nA : cA + (size_t)(t + 2) * kstep; const char* b2 = last ? nB : cB + (size_t)(t + 2) * kstep;
            const char* a3 = a2 + kstep; const char* b3 = b2 + kstep;
            if (last && has_next) S.a_ready(nxt);
            PG8_LDB(B0, 0, 0); PG8_SCHED; PG8_LDA(At, 0, 0); PG8_STAGE(PG8_SA(1, 1), a1 + hstep, voffA);
            PG8_WAIT_L(8); PG8_BAR; PG8_WAIT_L(0); PG8_MMA(0, 0, At, B0); PG8_BAR; PG8_SCHED;
            PG8_LDB(B1, 0, 1); PG8_STAGE(PG8_SB(0, 0), b2, voffB);
            PG8_BAR; PG8_WAIT_L(0); PG8_MMA(0, 1, At, B1); PG8_BAR;
            PG8_LDA(At, 0, 1); PG8_STAGE(PG8_SA(0, 0), a2, voffA);
            PG8_BAR; PG8_WAIT_L(0); PG8_MMA(1, 0, At, B0); PG8_BAR; PG8_SCHED;
            PG8_STAGE(PG8_SB(0, 1), b2 + hstep, voffB);
            PG8_WAIT_V(6); PG8_BAR; PG8_MMA(1, 1, At, B1); PG8_BAR;
            PG8_LDB(B0, 1, 0); PG8_SCHED; PG8_LDA(At, 1, 0); PG8_STAGE(PG8_SA(0, 1), a2 + hstep, voffA);
            PG8_WAIT_L(8); PG8_BAR; PG8_WAIT_L(0); PG8_MMA(0, 0, At, B0); PG8_BAR; PG8_SCHED;
            PG8_LDB(B1, 1, 1); PG8_STAGE(PG8_SB(1, 0), b3, voffB);
            PG8_BAR; PG8_WAIT_L(0); PG8_MMA(0, 1, At, B1); PG8_BAR;
            PG8_LDA(At, 1, 1); PG8_STAGE(PG8_SA(1, 0), a3, voffA);
            PG8_BAR; PG8_WAIT_L(0); PG8_MMA(1, 0, At, B0); PG8_BAR; PG8_SCHED;
            PG8_STAGE(PG8_SB(1, 1), b3 + hstep, voffB);
            PG8_WAIT_V(6); PG8_BAR; PG8_MMA(1, 1, At, B1); PG8_BAR;
        }
        PG8_STAMP();
        if constexpr (!Epi::AFTER_DRAIN) { E(acc, cur, wr, wc, fr, fq); S.done(cur); }
        PG8_STAMP();
        if (!has_next) break;
#pragma unroll
        for (int a = 0; a < 2; ++a)
#pragma unroll
            for (int b = 0; b < 2; ++b)
#pragma unroll
                for (int m = 0; m < 4; ++m)
#pragma unroll
                    for (int n = 0; n < 2; ++n) acc[a][b][m][n] = (f32x4){0.f, 0.f, 0.f, 0.f};
        cur = nxt; cA = nA; cB = nB; ++ui;
    }
    PG8_WAIT_V(0);
    if (wr == 0) PG8_BAR;
    PG8_BAR;
    if constexpr (Epi::AFTER_DRAIN) { E.fused(acc, cur, wr, wc, fr, fq, lds, wid, lane); S.done(cur); }
    PG8_STAMP();
    if (STAMP && wid == 0) { stamps[lane] = lane < nts ? (((unsigned long long)(unsigned)ts_hi << 32) | (unsigned)ts_lo) : 0ull;
        if (lane == 62) stamps[62] = rt_entry; if (lane == 63) stamps[63] = (unsigned long long)wall_clock64(); }
#undef PG8_STAMP
#undef PG8_SA
#undef PG8_SB
#undef PG8_STAGE
#undef PG8_LDA
#undef PG8_LDB
#undef PG8_MMA
#undef PG8_WAIT_V
#undef PG8_WAIT_L
#undef PG8_BAR
#undef PG8_SCHED
}
}

using pg8::bf16_t; using pg8::bf16x8; using pg8::f32x4; using pg8::u32x4;
typedef unsigned u32x2 __attribute__((ext_vector_type(2)));
typedef __bf16 bf16x2_t __attribute__((ext_vector_type(2)));
typedef float f32x2_t __attribute__((ext_vector_type(2)));
#define DI __device__ __forceinline__

constexpr int TOK = 24576, DM = 2048, NPROJ = 7168, RW = 1024;
constexpr float ALPHA = 1.189207115002721f;
constexpr float LOG2E = 1.4426950408889634f;
constexpr size_t MiB = 1048576;
constexpr size_t WS_R0 = 0;
constexpr size_t WS_R1 = 128 * MiB;
constexpr size_t WS_R2 = 224 * MiB;
constexpr size_t WS_R3 = 320 * MiB;
constexpr size_t WS_W  = 416 * MiB;
constexpr size_t WS_END = 460 * MiB;

struct Params {
    const float *x_prompt, *x_sample, *w_in, *rate_f, *rate_b, *gn_g, *conv_w, *w_out, *ln1_g, *ln1_b, *w_query, *keys1, *keys2, *peer_u, *peer_v, *ln2_g, *ln2_b;
    float* out; unsigned char* ws;
};

DI unsigned pk2(float a, float b) { f32x2_t v = {a, b}; return __builtin_bit_cast(unsigned, __builtin_convertvector(v, bf16x2_t)); }
DI float bf_lo(unsigned w) { return __uint_as_float(w << 16); }
DI float bf_hi(unsigned w) { return __uint_as_float(w & 0xffff0000u); }
DI f32x4 mfma16(bf16x8 a, bf16x8 b, f32x4 c) { return __builtin_amdgcn_mfma_f32_16x16x32_bf16(a, b, c, 0, 0, 0); }
DI float wave_sum(float x) { x += __shfl_xor(x, 1); x += __shfl_xor(x, 2); x += __shfl_xor(x, 4); x += __shfl_xor(x, 8); x += __shfl_xor(x, 16); x += __shfl_xor(x, 32); return x; }
DI float dot2bf(unsigned a, unsigned b, float c) { return __builtin_amdgcn_fdot2_f32_bf16(__builtin_bit_cast(bf16x2_t, a), __builtin_bit_cast(bf16x2_t, b), c, false); }
DI const float* xrow(const Params& p, int tok) { return tok < 8192 ? p.x_prompt + (size_t)tok * DM : p.x_sample + (size_t)(tok - 8192) * DM; }

DI int map_inproj(int c) {
    if (c < 2048) { const int blk = c >> 7, cc = c & 127, g = cc >> 3, j = cc & 7; return blk * 128 + 4 * g + (j & 3) + 64 * (j >> 2); }
    if (c < 4096) return c;
    if (c < 6144) { const int t = (c - 4096) >> 8, wi = (c - 4096) & 255, half = wi >> 7, col = wi & 127; return (half ? 6144 : 4096) + 128 * t + col; }
    return 5120 + (c - 6144);
}
template <bool MAPPED> DI void transpose_convert(const float* __restrict__ src, int ld, bf16_t* __restrict__ dst, int N, int bid, int nb) {
    const int lane = threadIdx.x & 63, w = threadIdx.x >> 6, nch = N / 256;
    for (int it = bid; it < nch * 32; it += nb) {
        const int chi = it % nch, k8hi = it / nch, c = chi * 256 + lane * 4, k8 = k8hi * 8 + w;
        const int sc = MAPPED ? map_inproj(c) : c;
        const float* sp = src + (size_t)(k8 * 8) * ld + sc;
        f32x4 v[8];
#pragma unroll
        for (int i = 0; i < 8; ++i) v[i] = *(const f32x4*)(sp + (size_t)i * ld);
#pragma unroll
        for (int cc = 0; cc < 4; ++cc) {
            u32x4 o; o.x = pk2(v[0][cc], v[1][cc]); o.y = pk2(v[2][cc], v[3][cc]); o.z = pk2(v[4][cc], v[5][cc]); o.w = pk2(v[6][cc], v[7][cc]);
            *(u32x4*)(dst + (size_t)(c + cc) * 2048 + k8 * 8) = o;
        }
    }
}
DI void convert_flat(const float* __restrict__ src, bf16_t* __restrict__ dst, size_t n8, int bid, int nb) {
    for (size_t i = (size_t)bid * 512 + threadIdx.x; i < n8; i += (size_t)nb * 512) {
        const float4 a = *(const float4*)(src + i * 8), b = *(const float4*)(src + i * 8 + 4);
        u32x4 o; o.x = pk2(a.x, a.y); o.y = pk2(a.z, a.w); o.z = pk2(b.x, b.y); o.w = pk2(b.z, b.w);
        *(u32x4*)(dst + i * 8) = o;
    }
}
DI void fold_phase(const float* __restrict__ wq, const float* __restrict__ k1, const float* __restrict__ k2, bf16_t* __restrict__ WqkT, unsigned char* lds, int bid, int nb) {
    float* sK = (float*)lds; float* sW = sK + 128 * 132;
    const int tid = threadIdx.x;
    for (int it = bid; it < 512; it += nb) {
        const int hh = it >> 5, kt = it & 31, head = hh >> 1, half = hh & 1;
        const float* keys = (half ? k2 : k1) + (size_t)head * 16384;
        __syncthreads();
        for (int p = tid; p < 4096; p += 512) { const int n = p >> 5, d4 = p & 31; *(float4*)(sK + n * 132 + d4 * 4) = *(const float4*)(keys + n * 128 + d4 * 4); }
        for (int p = tid; p < 2048; p += 512) { const int kk = p >> 5, d4 = p & 31; *(float4*)(sW + kk * 132 + d4 * 4) = *(const float4*)(wq + (size_t)(kt * 64 + kk) * 2048 + hh * 128 + d4 * 4); }
        __syncthreads();
        const int n = tid & 63, kq = tid >> 6;
        float acc0[8], acc1[8];
#pragma unroll
        for (int i = 0; i < 8; ++i) { acc0[i] = 0.f; acc1[i] = 0.f; }
        for (int d4 = 0; d4 < 32; ++d4) {
            const float4 ka = *(const float4*)(sK + n * 132 + d4 * 4), kb = *(const float4*)(sK + (n + 64) * 132 + d4 * 4);
#pragma unroll
            for (int i = 0; i < 8; ++i) { const float4 wv = *(const float4*)(sW + (kq * 8 + i) * 132 + d4 * 4);
                acc0[i] += ka.x * wv.x + ka.y * wv.y + ka.z * wv.z + ka.w * wv.w; acc1[i] += kb.x * wv.x + kb.y * wv.y + kb.z * wv.z + kb.w * wv.w; }
        }
        bf16_t* dst = WqkT + (size_t)(hh * 128 + n) * 2048 + kt * 64 + kq * 8;
        u32x4 o0, o1; o0.x = pk2(acc0[0], acc0[1]); o0.y = pk2(acc0[2], acc0[3]); o0.z = pk2(acc0[4], acc0[5]); o0.w = pk2(acc0[6], acc0[7]);
        o1.x = pk2(acc1[0], acc1[1]); o1.y = pk2(acc1[2], acc1[3]); o1.z = pk2(acc1[4], acc1[5]); o1.w = pk2(acc1[6], acc1[7]);
        *(u32x4*)dst = o0; *(u32x4*)(dst + (size_t)64 * 2048) = o1;
    }
}

struct EpiInProj {
    static constexpr bool PERM = true, AFTER_DRAIN = false;
    bf16_t *Q, *U, *BG;
    __device__ __forceinline__ void operator()(const f32x4 (&acc)[2][2][4][2], const pg8::Unit& u, int wr, int wc, int fr, int fq) const {
        const int pn = u.pn, row0 = u.pm * 256 + wr * 64 + fr, cl = wc * 32 + 8 * fq;
        if (pn < 8) {
            bf16_t* dst = Q + (size_t)(pn >> 2) * ((size_t)TOK * RW); const float sc = pn < 4 ? 1.0f : 0.08838834764831845f; const int colbase = (pn & 3) * 256 + cl;
            float cf[4];
#pragma unroll
            for (int e = 0; e < 4; ++e) cf[e] = exp2f(-(float)(cl / 2 + e) * 0.20762050593046014f) * 0.15915494309189535f;
#pragma unroll
            for (int ai = 0; ai < 2; ++ai)
#pragma unroll
                for (int m = 0; m < 4; ++m) {
                    const int row = row0 + ai * 128 + m * 16; const float pos = (float)(row & 8191);
                    float cs[4], sn[4];
#pragma unroll
                    for (int e = 0; e < 4; ++e) { const float pp = pos * cf[e], er = fmaf(pos, cf[e], -pp), frv = (pp - floorf(pp)) + er; sn[e] = __builtin_amdgcn_sinf(frv); cs[e] = __builtin_amdgcn_cosf(frv); }
#pragma unroll
                    for (int bj = 0; bj < 2; ++bj) {
                        const f32x4 x1 = acc[ai][bj][m][0], x2 = acc[ai][bj][m][1]; float o1[4], o2[4];
#pragma unroll
                        for (int e = 0; e < 4; ++e) { o1[e] = (x1[e] * cs[e] - x2[e] * sn[e]) * sc; o2[e] = (x1[e] * sn[e] + x2[e] * cs[e]) * sc; }
                        u32x4 w; w.x = pk2(o1[0], o1[1]); w.y = pk2(o1[2], o1[3]); w.z = pk2(o2[0], o2[1]); w.w = pk2(o2[2], o2[3]);
                        *(u32x4*)(dst + (size_t)row * RW + colbase + bj * 128) = w;
                    }
                }
        } else if (pn < 16 || pn >= 24) {
            bf16_t* dst = pn < 16 ? Q + (size_t)(pn >> 2) * ((size_t)TOK * RW) : BG; const int colbase = (pn & 3) * 256 + cl;
#pragma unroll
            for (int ai = 0; ai < 2; ++ai)
#pragma unroll
                for (int m = 0; m < 4; ++m) {
                    const int row = row0 + ai * 128 + m * 16;
#pragma unroll
                    for (int bj = 0; bj < 2; ++bj) {
                        const f32x4 v0 = acc[ai][bj][m][0], v1 = acc[ai][bj][m][1];
                        u32x4 w; w.x = pk2(v0[0], v0[1]); w.y = pk2(v0[2], v0[3]); w.z = pk2(v1[0], v1[1]); w.w = pk2(v1[2], v1[3]);
                        *(u32x4*)(dst + (size_t)row * RW + colbase + bj * 128) = w;
                    }
                }
        } else {
            const int colbase = (pn - 16) * 128 + cl;
#pragma unroll
            for (int ai = 0; ai < 2; ++ai)
#pragma unroll
                for (int m = 0; m < 4; ++m) {
                    const int row = row0 + ai * 128 + m * 16;
                    const f32x4 v0 = acc[ai][0][m][0] * acc[ai][1][m][0], v1 = acc[ai][0][m][1] * acc[ai][1][m][1];
                    u32x4 w; w.x = pk2(v0[0], v0[1]); w.y = pk2(v0[2], v0[3]); w.z = pk2(v1[0], v1[1]); w.w = pk2(v1[2], v1[3]);
                    *(u32x4*)(U + (size_t)row * RW + colbase) = w;
                }
        }
    }
};
struct EpiOutProj {
    static constexpr bool PERM = true, AFTER_DRAIN = false;
    bf16_t* Z;
    __device__ __forceinline__ void operator()(const f32x4 (&acc)[2][2][4][2], const pg8::Unit& u, int wr, int wc, int fr, int fq) const {
        const int row0 = u.pm * 256 + wr * 64 + fr, col0 = u.pn * 256 + wc * 32 + 8 * fq;
#pragma unroll
        for (int ai = 0; ai < 2; ++ai)
#pragma unroll
            for (int m = 0; m < 4; ++m) {
                const int row = row0 + ai * 128 + m * 16;
#pragma unroll
                for (int bj = 0; bj < 2; ++bj) {
                    const f32x4 v0 = acc[ai][bj][m][0], v1 = acc[ai][bj][m][1];
                    u32x4 w; w.x = pk2(v0[0], v0[1]); w.y = pk2(v0[2], v0[3]); w.z = pk2(v1[0], v1[1]); w.w = pk2(v1[2], v1[3]);
                    *(u32x4*)(Z + (size_t)row * DM + col0 + bj * 128) = w;
                }
            }
    }
};
struct EpiScore {
    static constexpr bool PERM = false, AFTER_DRAIN = false;
    float* C;
    __device__ __forceinline__ void operator()(const f32x4 (&acc)[2][2][4][2], const pg8::Unit& u, int wr, int wc, int fr, int fq) const {
        const int row0 = u.pm * 256 + wr * 64 + fr, col0 = u.pn * 256 + wc * 32 + 4 * fq;
#pragma unroll
        for (int ai = 0; ai < 2; ++ai)
#pragma unroll
            for (int m = 0; m < 4; ++m) { float* rowp = C + (size_t)(row0 + ai * 128 + m * 16) * DM + col0;
#pragma unroll
                for (int bj = 0; bj < 2; ++bj)
#pragma unroll
                    for (int n = 0; n < 2; ++n) *(f32x4*)(rowp + bj * 128 + n * 16) = acc[ai][bj][m][n]; }
    }
};

DI unsigned tile_off(int r, int j) { return (unsigned)(r * 256 + ((((j >> 3) ^ (r & 15))) << 4) + (j & 7) * 2); }
template <int E> DI unsigned short bfel(const u32x4& v) { const unsigned w = v[E >> 1]; return (unsigned short)((E & 1) ? (w >> 16) : (w & 0xffffu)); }
template <int E> DI float bfelf(const u32x4& v) { const unsigned w = v[E >> 1]; return (E & 1) ? bf_hi(w) : bf_lo(w); }

DI void r1_phase(const bf16_t* __restrict__ K, const bf16_t* __restrict__ V, bf16_t* __restrict__ KVf, bf16_t* __restrict__ KVb, const float* rate_f, const float* rate_b,
                 unsigned char* lds, int bid, int nb) {
    const int tid = threadIdx.x, lane = tid & 63, w = tid >> 6, m16 = lane & 15, quad = lane >> 4;
    unsigned char* sKf = lds; unsigned char* sKb = lds + 32768; unsigned char* sV = lds + 65536;
    for (int item = bid; item < 1536; item += nb) {
        const int hd = item & 7; const size_t T0 = (size_t)(item >> 3) * 128;
        const float lgf = -__expf(rate_f[hd]) * LOG2E, lgb = -__expf(rate_b[hd]) * LOG2E;
        __syncthreads();
#pragma unroll
        for (int i = 0; i < 2; ++i) {
            const int p = tid + 512 * i, j = (p >> 4) * 2, d8 = p & 15;
            const bf16_t* kp = K + (T0 + j) * RW + hd * 128 + d8 * 8; const bf16_t* vp = V + (T0 + j) * RW + hd * 128 + d8 * 8;
            const u32x4 k0 = *(const u32x4*)kp, k1 = *(const u32x4*)(kp + RW), v0 = *(const u32x4*)vp, v1 = *(const u32x4*)(vp + RW);
            const float zf0 = exp2f(lgf * (float)(127 - j)), zf1 = exp2f(lgf * (float)(126 - j)), zb0 = exp2f(lgb * (float)j), zb1 = exp2f(lgb * (float)(j + 1));
#define R1_EL(E) { const int d = d8 * 8 + E; const unsigned off = tile_off(d, j); const float ka = bfelf<E>(k0), kb = bfelf<E>(k1); \
                *(unsigned*)(sKf + off) = pk2(ka * zf0, kb * zf1); *(unsigned*)(sKb + off) = pk2(ka * zb0, kb * zb1); \
                *(unsigned*)(sV + off) = (unsigned)bfel<E>(v0) | ((unsigned)bfel<E>(v1) << 16); }
            R1_EL(0) R1_EL(1) R1_EL(2) R1_EL(3) R1_EL(4) R1_EL(5) R1_EL(6) R1_EL(7)
#undef R1_EL
        }
        __syncthreads();
        f32x4 af[8], ab[8];
#pragma unroll
        for (int mt = 0; mt < 8; ++mt) { af[mt] = (f32x4){0.f, 0.f, 0.f, 0.f}; ab[mt] = (f32x4){0.f, 0.f, 0.f, 0.f}; }
#pragma unroll
        for (int ks = 0; ks < 4; ++ks) {
            const int vr = 16 * w + m16;
            const bf16x8 bv = *(const bf16x8*)(sV + vr * 256 + ((((4 * ks + quad) ^ (vr & 15))) << 4));
#pragma unroll
            for (int mt = 0; mt < 8; ++mt) {
                const int r = 16 * mt + m16; const unsigned o = r * 256 + ((((4 * ks + quad) ^ (r & 15))) << 4);
                const bf16x8 a_f = *(const bf16x8*)(sKf + o), a_b = *(const bf16x8*)(sKb + o);
                af[mt] = mfma16(a_f, bv, af[mt]); ab[mt] = mfma16(a_b, bv, ab[mt]);
            }
        }
        const size_t ob = (size_t)item * 16384 + (size_t)(16 * w + m16) * 128 + 4 * quad;
#pragma unroll
        for (int mt = 0; mt < 8; ++mt) {
            u32x2 a; a.x = pk2(af[mt][0], af[mt][1]); a.y = pk2(af[mt][2], af[mt][3]); *(u32x2*)(KVf + ob + 16 * mt) = a;
            u32x2 b; b.x = pk2(ab[mt][0], ab[mt][1]); b.y = pk2(ab[mt][2], ab[mt][3]); *(u32x2*)(KVb + ob + 16 * mt) = b;
        }
    }
}

DI void r2_phase(const bf16_t* __restrict__ KVf, const bf16_t* __restrict__ KVb, bf16_t* __restrict__ Sf, bf16_t* __restrict__ Sb, const float* rate_f, const float* rate_b, int bid, int nb) {
    for (int g = bid * 512 + threadIdx.x; g < 98304; g += nb * 512) {
        const int dir = g / 49152, rem = g % 49152, sh = rem >> 11, piece = rem & 2047, s = sh >> 3, hd = sh & 7;
        const float lg = -__expf((dir ? rate_b : rate_f)[hd]) * LOG2E, Gc = exp2f(lg * 128.f);
        const bf16_t* src = dir ? KVb : KVf; bf16_t* dst = dir ? Sb : Sf;
        float st[8];
#pragma unroll
        for (int e = 0; e < 8; ++e) st[e] = 0.f;
        for (int cc = 0; cc < 64; ++cc) {
            const int c = dir ? 63 - cc : cc;
            const size_t off = ((size_t)((s * 64 + c) * 8 + hd)) * 16384 + (size_t)piece * 8;
            const u32x4 kv = *(const u32x4*)(src + off);
            u32x4 o; o.x = pk2(st[0], st[1]); o.y = pk2(st[2], st[3]); o.z = pk2(st[4], st[5]); o.w = pk2(st[6], st[7]);
            *(u32x4*)(dst + off) = o;
            st[0] = st[0] * Gc + bf_lo(kv.x); st[1] = st[1] * Gc + bf_hi(kv.x); st[2] = st[2] * Gc + bf_lo(kv.y); st[3] = st[3] * Gc + bf_hi(kv.y);
            st[4] = st[4] * Gc + bf_lo(kv.z); st[5] = st[5] * Gc + bf_hi(kv.z); st[6] = st[6] * Gc + bf_lo(kv.w); st[7] = st[7] * Gc + bf_hi(kv.w);
        }
    }
}

DI float silu_f(float x) { return x * __builtin_amdgcn_rcpf(1.0f + __builtin_amdgcn_exp2f(-x * LOG2E)); }

DI void r3_phase(const bf16_t* __restrict__ Q, const bf16_t* __restrict__ K, const bf16_t* __restrict__ V, const bf16_t* __restrict__ G, const bf16_t* __restrict__ Sf, const bf16_t* __restrict__ Sb,
                 const float* rate_f, const float* rate_b, const float* __restrict__ gn_g, bf16_t* __restrict__ mix, unsigned char* lds, int bid, int nb) {
    const int tid = threadIdx.x, lane = tid & 63, w = tid >> 6, m16 = lane & 15, quad = lane >> 4;
    unsigned char* sV = lds; unsigned char* sK = lds + 32768; unsigned char* sSf = lds + 65536; unsigned char* sSb = lds + 98304;
    for (int item = bid; item < 1536; item += nb) {
        const int hd = item & 7; const size_t T0 = (size_t)(item >> 3) * 128;
        const float lgf = -__expf(rate_f[hd]) * LOG2E, lgb = -__expf(rate_b[hd]) * LOG2E;
        __syncthreads();
#pragma unroll
        for (int i = 0; i < 4; ++i) {
            const int p = tid + 512 * i, r = p >> 4, c16 = p & 15;
            const unsigned o = (unsigned)(r * 256 + ((c16 ^ (r & 15)) << 4));
            *(u32x4*)(sK + o) = *(const u32x4*)(K + (T0 + r) * RW + hd * 128 + c16 * 8);
            *(u32x4*)(sSf + o) = *(const u32x4*)(Sf + (size_t)item * 16384 + r * 128 + c16 * 8);
            *(u32x4*)(sSb + o) = *(const u32x4*)(Sb + (size_t)item * 16384 + r * 128 + c16 * 8);
        }
#pragma unroll
        for (int i = 0; i < 2; ++i) {
            const int p = tid + 512 * i, j = (p >> 4) * 2, d8 = p & 15;
            const bf16_t* vp = V + (T0 + j) * RW + hd * 128 + d8 * 8;
            const u32x4 v0 = *(const u32x4*)vp, v1 = *(const u32x4*)(vp + RW);
#define R3_EL(E) { *(unsigned*)(sV + tile_off(d8 * 8 + E, j)) = (unsigned)bfel<E>(v0) | ((unsigned)bfel<E>(v1) << 16); }
            R3_EL(0) R3_EL(1) R3_EL(2) R3_EL(3) R3_EL(4) R3_EL(5) R3_EL(6) R3_EL(7)
#undef R3_EL
        }
        const int il = 16 * w + m16;
        const size_t tq = T0 + il;
        bf16x8 bq[4];
#pragma unroll
        for (int ks = 0; ks < 4; ++ks) bq[ks] = *(const bf16x8*)(Q + tq * RW + hd * 128 + 32 * ks + 8 * quad);
        __syncthreads();
        f32x4 aS[8];
#pragma unroll
        for (int mt = 0; mt < 8; ++mt) aS[mt] = (f32x4){0.f, 0.f, 0.f, 0.f};
#pragma unroll
        for (int ks = 0; ks < 4; ++ks)
#pragma unroll
            for (int mt = 0; mt < 8; ++mt) {
                const int r = 16 * mt + m16;
                const bf16x8 ak = *(const bf16x8*)(sK + r * 256 + ((((4 * ks + quad) ^ (r & 15))) << 4));
                aS[mt] = mfma16(ak, bq[ks], aS[mt]);
            }
        bf16x8 bp[4];
#pragma unroll
        for (int s = 0; s < 4; ++s) {
            float pv[8];
#pragma unroll
            for (int t = 0; t < 8; ++t) {
                const int mt = 2 * s + (t >> 2), r = t & 3, j = 16 * mt + 4 * quad + r, dl = il - j;
                const float dec = dl > 0 ? __builtin_amdgcn_exp2f(lgf * (float)dl) : (dl < 0 ? __builtin_amdgcn_exp2f(lgb * (float)(-dl)) : 2.0f);
                pv[t] = aS[mt][r] * dec;
            }
            u32x4 pk; pk.x = pk2(pv[0], pv[1]); pk.y = pk2(pv[2], pv[3]); pk.z = pk2(pv[4], pv[5]); pk.w = pk2(pv[6], pv[7]);
            bp[s] = __builtin_bit_cast(bf16x8, pk);
        }
        f32x4 aO[8];
#pragma unroll
        for (int mt = 0; mt < 8; ++mt) aO[mt] = (f32x4){0.f, 0.f, 0.f, 0.f};
#pragma unroll
        for (int s = 0; s < 4; ++s)
#pragma unroll
            for (int mt = 0; mt < 8; ++mt) {
                const int row = 16 * mt + m16;
                const u32x2 lo = *(const u32x2*)(sV + row * 256 + ((((4 * s + (quad >> 1)) ^ (row & 15))) << 4) + (quad & 1) * 8);
                const u32x2 hi = *(const u32x2*)(sV + row * 256 + ((((4 * s + 2 + (quad >> 1)) ^ (row & 15))) << 4) + (quad & 1) * 8);
                u32x4 av; av.x = lo.x; av.y = lo.y; av.z = hi.x; av.w = hi.y;
                aO[mt] = mfma16(__builtin_bit_cast(bf16x8, av), bp[s], aO[mt]);
            }
#pragma unroll
        for (int dir = 0; dir < 2; ++dir) {
            const unsigned char* sS = dir ? sSb : sSf;
            f32x4 aX[8];
#pragma unroll
            for (int mt = 0; mt < 8; ++mt) aX[mt] = (f32x4){0.f, 0.f, 0.f, 0.f};
#pragma unroll
            for (int ks = 0; ks < 4; ++ks)
#pragma unroll
                for (int mt = 0; mt < 8; ++mt) {
                    const int r = 16 * mt + m16;
                    const bf16x8 a = *(const bf16x8*)(sS + r * 256 + ((((4 * ks + quad) ^ (r & 15))) << 4));
                    aX[mt] = mfma16(a, bq[ks], aX[mt]);
                }
            const float xi = dir ? exp2f(lgb * (float)(128 - il)) : exp2f(lgf * (float)(il + 1));
#pragma unroll
            for (int mt = 0; mt < 8; ++mt) aO[mt] += xi * aX[mt];
        }
        float sum = 0.f;
#pragma unroll
        for (int mt = 0; mt < 8; ++mt) sum += (aO[mt][0] + aO[mt][1]) + (aO[mt][2] + aO[mt][3]);
        sum += __shfl_xor(sum, 16); sum += __shfl_xor(sum, 32);
        const float mu = sum * (1.0f / 128.0f); float qv = 0.f;
#pragma unroll
        for (int mt = 0; mt < 8; ++mt) { const f32x4 d = aO[mt] - mu; qv += (d[0] * d[0] + d[1] * d[1]) + (d[2] * d[2] + d[3] * d[3]); }
        qv += __shfl_xor(qv, 16); qv += __shfl_xor(qv, 32);
        const float rstd = rsqrtf(qv * (1.0f / 128.0f) + 1e-6f);
#pragma unroll
        for (int mt = 0; mt < 8; ++mt) {
            const int dv0 = 16 * mt + 4 * quad;
            const u32x2 gg = *(const u32x2*)(G + tq * RW + hd * 128 + dv0); const f32x4 gn = *(const f32x4*)(gn_g + hd * 128 + dv0);
            const float o0 = (aO[mt][0] - mu) * rstd * gn[0] * silu_f(bf_lo(gg.x)), o1 = (aO[mt][1] - mu) * rstd * gn[1] * silu_f(bf_hi(gg.x));
            const float o2 = (aO[mt][2] - mu) * rstd * gn[2] * silu_f(bf_lo(gg.y)), o3 = (aO[mt][3] - mu) * rstd * gn[3] * silu_f(bf_hi(gg.y));
            u32x2 o; o.x = pk2(o0, o1); o.y = pk2(o2, o3);
            *(u32x2*)(mix + tq * DM + hd * 128 + dv0) = o;
        }
    }
}

DI void conv_phase(const bf16_t* __restrict__ U, const bf16_t* __restrict__ BG, const float* __restrict__ cw, bf16_t* __restrict__ mix, int bid, int nb) {
    for (size_t i = (size_t)bid * 512 + threadIdx.x; i < (size_t)TOK * 128; i += (size_t)nb * 512) {
        const size_t t = i >> 7; const int c8 = (int)(i & 127) * 8, pos = (int)(t & 8191);
        const u32x4 zero = {0u, 0u, 0u, 0u};
        const u32x4 u1 = *(const u32x4*)(U + t * RW + c8);
        const u32x4 u0 = pos > 0 ? *(const u32x4*)(U + (t - 1) * RW + c8) : zero;
        const u32x4 u2 = pos < 8191 ? *(const u32x4*)(U + (t + 1) * RW + c8) : zero;
        const u32x4 bg = *(const u32x4*)(BG + t * RW + c8);
        const f32x4 w0a = *(const f32x4*)(cw + c8), w0b = *(const f32x4*)(cw + c8 + 4), w1a = *(const f32x4*)(cw + 1024 + c8), w1b = *(const f32x4*)(cw + 1024 + c8 + 4),
                    w2a = *(const f32x4*)(cw + 2048 + c8), w2b = *(const f32x4*)(cw + 2048 + c8 + 4);
        float r[8];
#define CV(E, WA, IDX) r[E] = bfelf<E>(bg) * (WA##0[IDX] * bfelf<E>(u0) + WA##1[IDX] * bfelf<E>(u1) + WA##2[IDX] * bfelf<E>(u2));
        { const f32x4 A0 = w0a, A1 = w1a, A2 = w2a, B0 = w0b, B1 = w1b, B2 = w2b;
          CV(0, A, 0) CV(1, A, 1) CV(2, A, 2) CV(3, A, 3) CV(4, B, 0) CV(5, B, 1) CV(6, B, 2) CV(7, B, 3) }
#undef CV
        u32x4 o; o.x = pk2(r[0], r[1]); o.y = pk2(r[2], r[3]); o.z = pk2(r[4], r[5]); o.w = pk2(r[6], r[7]);
        *(u32x4*)(mix + t * DM + 1024 + c8) = o;
    }
}

DI void ln1_phase(const bf16_t* __restrict__ Z, const bf16_t* __restrict__ X, const float* __restrict__ g, const float* __restrict__ b, bf16_t* __restrict__ H, int bid, int nb) {
    const int lane = threadIdx.x & 63, w = threadIdx.x >> 6;
    for (int row = bid * 8 + w; row < TOK; row += nb * 8) {
        u32x4 zv[4], xv[4]; float v[32];
#pragma unroll
        for (int i = 0; i < 4; ++i) { zv[i] = *(const u32x4*)(Z + (size_t)row * DM + (lane + 64 * i) * 8); xv[i] = *(const u32x4*)(X + (size_t)row * DM + (lane + 64 * i) * 8); }
        float s = 0.f;
#pragma unroll
        for (int i = 0; i < 4; ++i)
#pragma unroll
            for (int k = 0; k < 4; ++k) { v[8 * i + 2 * k] = bf_lo(zv[i][k]) + ALPHA * bf_lo(xv[i][k]); v[8 * i + 2 * k + 1] = bf_hi(zv[i][k]) + ALPHA * bf_hi(xv[i][k]); s += v[8 * i + 2 * k] + v[8 * i + 2 * k + 1]; }
        s = wave_sum(s); const float mu = s * (1.0f / 2048.0f); float q = 0.f;
#pragma unroll
        for (int k = 0; k < 32; ++k) { const float d = v[k] - mu; q += d * d; }
        q = wave_sum(q); const float rstd = rsqrtf(q * (1.0f / 2048.0f) + 1e-5f);
#pragma unroll
        for (int i = 0; i < 4; ++i) {
            const int c0 = (lane + 64 * i) * 8;
            const f32x4 ga = *(const f32x4*)(g + c0), gb = *(const f32x4*)(g + c0 + 4), ba = *(const f32x4*)(b + c0), bb = *(const f32x4*)(b + c0 + 4);
            u32x4 o;
            o.x = pk2((v[8 * i + 0] - mu) * rstd * ga[0] + ba[0], (v[8 * i + 1] - mu) * rstd * ga[1] + ba[1]);
            o.y = pk2((v[8 * i + 2] - mu) * rstd * ga[2] + ba[2], (v[8 * i + 3] - mu) * rstd * ga[3] + ba[3]);
            o.z = pk2((v[8 * i + 4] - mu) * rstd * gb[0] + bb[0], (v[8 * i + 5] - mu) * rstd * gb[1] + bb[1]);
            o.w = pk2((v[8 * i + 6] - mu) * rstd * gb[2] + bb[2], (v[8 * i + 7] - mu) * rstd * gb[3] + bb[3]);
            *(u32x4*)(H + (size_t)row * DM + c0) = o;
        }
    }
}


DI void table_fp4_phase(const float* __restrict__ src, unsigned char* __restrict__ dst, float* __restrict__ scale, int bid, int nb) {
    const int lane = threadIdx.x & 63, w = threadIdx.x >> 6;
    for (int row = bid * 8 + w; row < 16384; row += nb * 8) {
        f32x4 v[8]; float am = 0.f;
#pragma unroll
        for (int k = 0; k < 8; ++k) { v[k] = *(const f32x4*)(src + (size_t)row * DM + lane * 32 + 4 * k);
            am = fmaxf(am, fmaxf(fmaxf(fabsf(v[k][0]), fabsf(v[k][1])), fmaxf(fabsf(v[k][2]), fabsf(v[k][3])))); }
        am = fmaxf(am, __shfl_xor(am, 1)); am = fmaxf(am, __shfl_xor(am, 2)); am = fmaxf(am, __shfl_xor(am, 4)); am = fmaxf(am, __shfl_xor(am, 8)); am = fmaxf(am, __shfl_xor(am, 16)); am = fmaxf(am, __shfl_xor(am, 32));
        const float sc = am > 0.f ? am * (0.8f / 6.0f) : 1.0f, inv = 1.0f / sc;
        if (lane == 0) scale[row] = sc;
        u32x4 o;
#pragma unroll
        for (int k = 0; k < 4; ++k) {
            unsigned wd = 0;
            wd = __builtin_amdgcn_cvt_scalef32_pk_fp4_f32(wd, v[2 * k][0] * inv, v[2 * k][1] * inv, 1.0f, 0);
            wd = __builtin_amdgcn_cvt_scalef32_pk_fp4_f32(wd, v[2 * k][2] * inv, v[2 * k][3] * inv, 1.0f, 1);
            wd = __builtin_amdgcn_cvt_scalef32_pk_fp4_f32(wd, v[2 * k + 1][0] * inv, v[2 * k + 1][1] * inv, 1.0f, 2);
            wd = __builtin_amdgcn_cvt_scalef32_pk_fp4_f32(wd, v[2 * k + 1][2] * inv, v[2 * k + 1][3] * inv, 1.0f, 3);
            o[k] = wd;
        }
        *(u32x4*)(dst + ((size_t)(lane >> 3) * 16384 + row) * 128 + (lane & 7) * 16) = o;
    }
}

#define INS16(r, x) { _Pragma("unroll") for (int j_ = 15; j_ >= 1; --j_) r[j_] = __builtin_amdgcn_fmed3f(r[j_ - 1], r[j_], x); r[0] = fmaxf(r[0], x); }
DI float gelu_f(float x) { return 0.5f * x * (1.0f + erff(x * 0.7071067811865476f)); }


DI void route_phase(const float* __restrict__ scores, int* __restrict__ sel_eid, float* __restrict__ sel_gate, unsigned char* lds, int bid, int nb) {
    const int full = nb * 512 < TOK * 8 ? nb * 512 : TOK * 8, rest = TOK * 8 - full;
    int pb = rest > 0 ? (rest + nb - 1) / nb : 0; if (pb > 512) pb = 512;
    for (int seg = 0; seg < 2; ++seg)
    for (int row = seg == 0 ? bid * 512 + (int)threadIdx.x : ((int)threadIdx.x < pb ? full + bid * pb + (int)threadIdx.x : TOK * 8); row < (seg == 0 ? full : TOK * 8); row += (seg == 0 ? nb * 512 : nb * pb)) {
        const size_t tok = (size_t)(row >> 3); const int head = row & 7;
        const float4* sp = (const float4*)(scores + tok * DM + head * 256);
        float r1[16], r2[16];
#pragma unroll
        for (int j = 0; j < 16; ++j) { r1[j] = -INFINITY; r2[j] = -INFINITY; }
#define RT_INS(R, V, IDX) { const float x_ = __uint_as_float((__float_as_uint(V) & 0xffffff80u) | (unsigned)(IDX)); INS16(R, x_) }
        for (int i8 = 0; i8 < 4; ++i8) {
            float4 a[8];
#pragma unroll
            for (int q = 0; q < 8; ++q) a[q] = sp[8 * i8 + q];
#pragma unroll
            for (int q = 0; q < 8; ++q) { const int b4 = 4 * (8 * i8 + q); RT_INS(r1, a[q].x, b4) RT_INS(r1, a[q].y, b4 + 1) RT_INS(r1, a[q].z, b4 + 2) RT_INS(r1, a[q].w, b4 + 3) }
        }
        for (int i8 = 0; i8 < 4; ++i8) {
            float4 a[8];
#pragma unroll
            for (int q = 0; q < 8; ++q) a[q] = sp[32 + 8 * i8 + q];
#pragma unroll
            for (int q = 0; q < 8; ++q) { const int b4 = 4 * (8 * i8 + q); RT_INS(r2, a[q].x, b4) RT_INS(r2, a[q].y, b4 + 1) RT_INS(r2, a[q].z, b4 + 2) RT_INS(r2, a[q].w, b4 + 3) }
        }
#undef RT_INS
        unsigned* sidx = (unsigned*)lds;
#pragma unroll
        for (int d = 0; d < 4; ++d) {
            sidx[d * 512 + threadIdx.x] = (__float_as_uint(r1[4 * d]) & 127u) | ((__float_as_uint(r1[4 * d + 1]) & 127u) << 8) | ((__float_as_uint(r1[4 * d + 2]) & 127u) << 16) | ((__float_as_uint(r1[4 * d + 3]) & 127u) << 24);
            sidx[(4 + d) * 512 + threadIdx.x] = (__float_as_uint(r2[4 * d]) & 127u) | ((__float_as_uint(r2[4 * d + 1]) & 127u) << 8) | ((__float_as_uint(r2[4 * d + 2]) & 127u) << 16) | ((__float_as_uint(r2[4 * d + 3]) & 127u) << 24);
        }
        float bk[16];
#pragma unroll
        for (int j = 0; j < 16; ++j) bk[j] = -INFINITY;
#pragma unroll
        for (int a = 0; a < 16; ++a)
#pragma unroll
            for (int b = 0; b < 16; ++b)
                if ((a + 1) * (b + 1) <= 16) {
                    const float ksum = __uint_as_float(__float_as_uint(r1[a]) & 0xffffff80u) + __uint_as_float(__float_as_uint(r2[b]) & 0xffffff80u);
                    const float key = __uint_as_float((__float_as_uint(ksum) & 0xffffff00u) | (unsigned)(a * 16 + b));
                    INS16(bk, key)
                }
        int bpay[16];
#pragma unroll
        for (int j = 0; j < 16; ++j) {
            const unsigned pos = __float_as_uint(bk[j]) & 255u, pa = pos >> 4, pb = pos & 15u;
            const unsigned i1 = (sidx[(pa >> 2) * 512 + threadIdx.x] >> (8 * (pa & 3))) & 127u, i2 = (sidx[(4 + (pb >> 2)) * 512 + threadIdx.x] >> (8 * (pb & 3))) & 127u;
            bpay[j] = (int)((i1 << 7) | i2);
        }
        float ex[16], ssum = 0.f;
#pragma unroll
        for (int j = 0; j < 16; ++j) { ex[j] = __expf(bk[j] - bk[0]); ssum += ex[j]; }
        const float inv = 1.0f / ssum;
        int* ed = sel_eid + tok * 128 + head * 16; float* gd = sel_gate + tok * 128 + head * 16;
#pragma unroll
        for (int j4 = 0; j4 < 4; ++j4) {
            *(int4*)(ed + 4 * j4) = make_int4(bpay[4 * j4], bpay[4 * j4 + 1], bpay[4 * j4 + 2], bpay[4 * j4 + 3]);
            *(float4*)(gd + 4 * j4) = make_float4(ex[4 * j4] * inv, ex[4 * j4 + 1] * inv, ex[4 * j4 + 2] * inv, ex[4 * j4 + 3] * inv);
        }
    }
}

template <int CTRL> DI float dpp_f(float x) { return __int_as_float(__builtin_amdgcn_update_dpp(0, __float_as_int(x), CTRL, 0xf, 0xf, false)); }
DI float sum8(float x) { x += dpp_f<0xB1>(x); x += dpp_f<0x4E>(x); x += dpp_f<0x141>(x); return x; }
#define FP4PAIR(wd, b) __builtin_amdgcn_cvt_scalef32_pk_f32_fp4((wd), 1.0f, (b))
DI void peerA_step(u32x4 (&cur)[16], u32x4 (&nxt)[16], const u32x4 (&hcur)[4], u32x4 (&hnxt)[4], int (&eidN)[16], const unsigned char* Ubase, unsigned loff,
                   const bf16_t* hn_ptr, const int* epnn, float* pp, bool do_store, int g, int j) {
#pragma unroll
    for (int i = 0; i < 16; ++i) nxt[i] = *(const u32x4*)(Ubase + (((unsigned)eidN[i] << 7) + loff));
#pragma unroll
    for (int k = 0; k < 4; ++k) hnxt[k] = (*(const u32x4*)(hn_ptr + 8 * k));
#pragma unroll
    for (int i = 0; i < 16; ++i) eidN[i] = (*(epnn + 8 * i));
    unsigned hw[16];
#pragma unroll
    for (int k = 0; k < 4; ++k) { hw[4 * k] = hcur[k].x; hw[4 * k + 1] = hcur[k].y; hw[4 * k + 2] = hcur[k].z; hw[4 * k + 3] = hcur[k].w; }
#pragma unroll
    for (int q = 0; q < 16; ++q) asm volatile("" : "+v"(hw[q]));
    float part[16];
#pragma unroll
    for (int i = 0; i < 16; ++i) {
        float a = 0.f;
#pragma unroll
        for (int k = 0; k < 4; ++k) {
            a = __builtin_amdgcn_fdot2_f32_bf16(__builtin_amdgcn_cvt_scalef32_pk_bf16_fp4(cur[i][k], 1.0f, 0), __builtin_bit_cast(bf16x2_t, hw[4 * k + 0]), a, false);
            a = __builtin_amdgcn_fdot2_f32_bf16(__builtin_amdgcn_cvt_scalef32_pk_bf16_fp4(cur[i][k], 1.0f, 1), __builtin_bit_cast(bf16x2_t, hw[4 * k + 1]), a, false);
            a = __builtin_amdgcn_fdot2_f32_bf16(__builtin_amdgcn_cvt_scalef32_pk_bf16_fp4(cur[i][k], 1.0f, 2), __builtin_bit_cast(bf16x2_t, hw[4 * k + 2]), a, false);
            a = __builtin_amdgcn_fdot2_f32_bf16(__builtin_amdgcn_cvt_scalef32_pk_bf16_fp4(cur[i][k], 1.0f, 3), __builtin_bit_cast(bf16x2_t, hw[4 * k + 3]), a, false);
        }
        part[i] = a;
    }
    const bool b0 = (j & 1) != 0, b1 = (j & 2) != 0, b2 = (j & 4) != 0;
    float r8[8], r4[4], r2[2];
#pragma unroll
    for (int k = 0; k < 8; ++k) { const float keep = b0 ? part[8 + k] : part[k], send = b0 ? part[k] : part[8 + k]; r8[k] = keep + dpp_f<0xB1>(send); }
#pragma unroll
    for (int k = 0; k < 4; ++k) { const float keep = b1 ? r8[4 + k] : r8[k], send = b1 ? r8[k] : r8[4 + k]; r4[k] = keep + dpp_f<0x4E>(send); }
#pragma unroll
    for (int k = 0; k < 2; ++k) { const float keep = b2 ? r4[2 + k] : r4[k], send = b2 ? r4[k] : r4[2 + k]; r2[k] = keep + dpp_f<0x1B>(dpp_f<0x141>(send)); }
    const int i0 = (b0 ? 8 : 0) + (b1 ? 4 : 0) + (b2 ? 2 : 0);
    if (do_store) { __builtin_nontemporal_store(r2[0], pp + 8 * i0 + g); __builtin_nontemporal_store(r2[1], pp + 8 * i0 + 8 + g); }
}
DI void peerA_phase(const bf16_t* __restrict__ H, const unsigned char* __restrict__ U4, const int* __restrict__ sel_eid, float* __restrict__ P, int bid, int nb) {
    const int lane = threadIdx.x & 63, w = threadIdx.x >> 6, g = lane >> 3, j = lane & 7;
    const int s = bid & 7, nxb = nb >> 3;
    if ((bid >> 3) >= nxb) return;
    const int widx = (bid >> 3) * 8 + w, nw = nxb * 8;
    const int ntok = (TOK - widx + nw - 1) / nw;
    const size_t coff = (size_t)(256 * s + 32 * j); const unsigned char* Ubase = U4 + (size_t)s * (16384 * 128); const unsigned loff = 16u * j;
    int eidN[16]; u32x4 uvA[16], uvB[16]; u32x4 hA[4], hB[4];
    {   const int t0 = widx, t1 = ntok > 1 ? widx + nw : widx;
        const int* ep = sel_eid + (size_t)t0 * 128 + g;
#pragma unroll
        for (int i = 0; i < 16; ++i) eidN[i] = (*(ep + 8 * i));
#pragma unroll
        for (int k = 0; k < 4; ++k) hA[k] = (*(const u32x4*)(H + (size_t)t0 * DM + coff + 8 * k));
#pragma unroll
        for (int i = 0; i < 16; ++i) uvA[i] = *(const u32x4*)(Ubase + (((unsigned)eidN[i] << 7) + loff));
        ep = sel_eid + (size_t)t1 * 128 + g;
#pragma unroll
        for (int i = 0; i < 16; ++i) eidN[i] = (*(ep + 8 * i));
    }
#define TOKC(x) (widx + ((x) < ntok ? (x) : ntok - 1) * nw)
    for (int it = 0; it < ntok; it += 2) {
        {   const int t = TOKC(it), tn = TOKC(it + 1), tnn = TOKC(it + 2);
            peerA_step(uvA, uvB, hA, hB, eidN, Ubase, loff, H + (size_t)tn * DM + coff, sel_eid + (size_t)tnn * 128 + g, P + ((size_t)t * 8 + s) * 128, true, g, j); }
        {   const int t = TOKC(it + 1), tn = TOKC(it + 2), tnn = TOKC(it + 3);
            peerA_step(uvB, uvA, hB, hA, eidN, Ubase, loff, H + (size_t)tn * DM + coff, sel_eid + (size_t)tnn * 128 + g, P + ((size_t)t * 8 + s) * 128, it + 1 < ntok, g, j); }
    }
}
DI void peerC_phase(const float* __restrict__ P, const int* __restrict__ sel_eid, const float* __restrict__ sel_gate, const float* __restrict__ Us, const float* __restrict__ Vs, float* __restrict__ C, int bid, int nb) {
    const int lane = threadIdx.x & 63, w = threadIdx.x >> 6;
    for (int t = bid * 8 + w; t < TOK; t += nb * 8) {
        const float* pp = P + (size_t)t * 1024;
        float d0 = 0.f, d1 = 0.f;
#pragma unroll
        for (int s = 0; s < 8; ++s) { d0 += pp[s * 128 + lane]; d1 += pp[s * 128 + 64 + lane]; }
        const int e0 = sel_eid[(size_t)t * 128 + lane], e1 = sel_eid[(size_t)t * 128 + 64 + lane];
        C[(size_t)t * 128 + lane] = sel_gate[(size_t)t * 128 + lane] * Vs[e0] * gelu_f(d0 * Us[e0]);
        C[(size_t)t * 128 + 64 + lane] = sel_gate[(size_t)t * 128 + 64 + lane] * Vs[e1] * gelu_f(d1 * Us[e1]);
    }
}
DI void peerB_step(u32x4 (&cur)[16], u32x4 (&nxt)[16], const float (&cfcur)[16], float (&cfnxt)[16], int (&eidN)[16], const unsigned char* Vbase, unsigned loff,
                   const float* cpn, const int* epnn, bf16_t* op, bool do_store, bool b3) {
#pragma unroll
    for (int i = 0; i < 16; ++i) nxt[i] = *(const u32x4*)(Vbase + (((unsigned)eidN[i] << 7) + loff));
#pragma unroll
    for (int i = 0; i < 16; ++i) { eidN[i] = (*(epnn + 8 * i)); cfnxt[i] = (*(cpn + 8 * i)); }
    f32x2_t o[16];
#pragma unroll
    for (int k = 0; k < 16; ++k) o[k] = (f32x2_t){0.f, 0.f};
#pragma unroll
    for (int i = 0; i < 16; ++i) {
        const f32x2_t c2 = {cfcur[i], cfcur[i]};
#pragma unroll
        for (int k = 0; k < 4; ++k) {
            o[4 * k + 0] = FP4PAIR(cur[i][k], 0) * c2 + o[4 * k + 0]; o[4 * k + 1] = FP4PAIR(cur[i][k], 1) * c2 + o[4 * k + 1];
            o[4 * k + 2] = FP4PAIR(cur[i][k], 2) * c2 + o[4 * k + 2]; o[4 * k + 3] = FP4PAIR(cur[i][k], 3) * c2 + o[4 * k + 3];
        }
    }
    f32x2_t q8[8];
#pragma unroll
    for (int k = 0; k < 8; ++k) {
        const u32x2 sx = __builtin_amdgcn_permlane32_swap(__float_as_uint(o[k].x), __float_as_uint(o[8 + k].x), false, false);
        const u32x2 sy = __builtin_amdgcn_permlane32_swap(__float_as_uint(o[k].y), __float_as_uint(o[8 + k].y), false, false);
        q8[k] = (f32x2_t){__uint_as_float(sx.x) + __uint_as_float(sx.y), __uint_as_float(sy.x) + __uint_as_float(sy.y)};
    }
    f32x2_t q4[4];
#pragma unroll
    for (int k = 0; k < 4; ++k) {
        const u32x2 sx = __builtin_amdgcn_permlane16_swap(__float_as_uint(q8[k].x), __float_as_uint(q8[4 + k].x), false, false);
        const u32x2 sy = __builtin_amdgcn_permlane16_swap(__float_as_uint(q8[k].y), __float_as_uint(q8[4 + k].y), false, false);
        q4[k] = (f32x2_t){__uint_as_float(sx.x) + __uint_as_float(sx.y), __uint_as_float(sy.x) + __uint_as_float(sy.y)};
    }
    f32x4 fin;
#pragma unroll
    for (int k = 0; k < 2; ++k) {
        const f32x2_t keep = b3 ? q4[2 + k] : q4[k], send = b3 ? q4[k] : q4[2 + k];
        fin[2 * k] = keep.x + dpp_f<0x128>(send.x); fin[2 * k + 1] = keep.y + dpp_f<0x128>(send.y);
    }
    if (do_store) { u32x2 fo; fo.x = pk2(fin[0], fin[1]); fo.y = pk2(fin[2], fin[3]); __builtin_nontemporal_store(fo, (u32x2*)op); }
}
DI void peerB_phase(const unsigned char* __restrict__ V4, const int* __restrict__ sel_eid, const float* __restrict__ C, float* __restrict__ outpre, int bid, int nb) {
    const int lane = threadIdx.x & 63, w = threadIdx.x >> 6, g = lane >> 3, j = lane & 7;
    const int s = bid & 7, nxb = nb >> 3;
    if ((bid >> 3) >= nxb) return;
    const int widx = (bid >> 3) * 8 + w, nw = nxb * 8;
    const int ntok = (TOK - widx + nw - 1) / nw;
    const bool b5 = (lane & 32) != 0, b4 = (lane & 16) != 0, b3 = (lane & 8) != 0;
    const int qidx = (b5 ? 4 : 0) + (b4 ? 2 : 0) + (b3 ? 1 : 0);
    const size_t coff = (size_t)(256 * s + 32 * j) + 4 * qidx; const unsigned char* Vbase = V4 + (size_t)s * (16384 * 128); const unsigned loff = 16u * j;
    int eidN[16]; float cfA[16], cfB[16]; u32x4 vvA[16], vvB[16];
    {   const int t0 = widx, t1 = ntok > 1 ? widx + nw : widx;
        const int* ep = sel_eid + (size_t)t0 * 128 + g; const float* cp = C + (size_t)t0 * 128 + g;
#pragma unroll
        for (int i = 0; i < 16; ++i) { eidN[i] = (*(ep + 8 * i)); cfA[i] = (*(cp + 8 * i)); }
#pragma unroll
        for (int i = 0; i < 16; ++i) vvA[i] = *(const u32x4*)(Vbase + (((unsigned)eidN[i] << 7) + loff));
        ep = sel_eid + (size_t)t1 * 128 + g;
#pragma unroll
        for (int i = 0; i < 16; ++i) eidN[i] = (*(ep + 8 * i));
    }
    for (int it = 0; it < ntok; it += 2) {
        {   const int t = TOKC(it), tn = TOKC(it + 1), tnn = TOKC(it + 2);
            peerB_step(vvA, vvB, cfA, cfB, eidN, Vbase, loff, C + (size_t)tn * 128 + g, sel_eid + (size_t)tnn * 128 + g, (bf16_t*)(outpre + (size_t)t * DM) + coff, true, b3); }
        {   const int t = TOKC(it + 1), tn = TOKC(it + 2), tnn = TOKC(it + 3);
            peerB_step(vvB, vvA, cfB, cfA, eidN, Vbase, loff, C + (size_t)tn * 128 + g, sel_eid + (size_t)tnn * 128 + g, (bf16_t*)(outpre + (size_t)t * DM) + coff, it + 1 < ntok, b3); }
    }
#undef TOKC
}
DI void ln2_phase(const bf16_t* __restrict__ H, float* io, const float* __restrict__ g, const float* __restrict__ b, int bid, int nb) {
    const int lane = threadIdx.x & 63, w = threadIdx.x >> 6;
    for (int t = bid * 8 + w; t < TOK; t += nb * 8) {
        float v[32]; float s = 0.f;
#pragma unroll
        for (int i = 0; i < 4; ++i) {
            const int c0 = (lane + 64 * i) * 8;
            const u32x4 hv = *(const u32x4*)(H + (size_t)t * DM + c0);
            const u32x4 ov = *(const u32x4*)((const bf16_t*)(io + (size_t)t * DM) + c0);
            const f32x4 a = {bf_lo(ov.x), bf_hi(ov.x), bf_lo(ov.y), bf_hi(ov.y)}, c = {bf_lo(ov.z), bf_hi(ov.z), bf_lo(ov.w), bf_hi(ov.w)};
            v[8 * i + 0] = a[0] + ALPHA * bf_lo(hv[0]); v[8 * i + 1] = a[1] + ALPHA * bf_hi(hv[0]); v[8 * i + 2] = a[2] + ALPHA * bf_lo(hv[1]); v[8 * i + 3] = a[3] + ALPHA * bf_hi(hv[1]);
            v[8 * i + 4] = c[0] + ALPHA * bf_lo(hv[2]); v[8 * i + 5] = c[1] + ALPHA * bf_hi(hv[2]); v[8 * i + 6] = c[2] + ALPHA * bf_lo(hv[3]); v[8 * i + 7] = c[3] + ALPHA * bf_hi(hv[3]);
#pragma unroll
            for (int k = 0; k < 8; ++k) s += v[8 * i + k];
        }
        s = wave_sum(s); const float mu = s * (1.0f / 2048.0f); float q = 0.f;
#pragma unroll
        for (int k = 0; k < 32; ++k) { const float d = v[k] - mu; q += d * d; }
        q = wave_sum(q); const float rstd = rsqrtf(q * (1.0f / 2048.0f) + 1e-5f);
#pragma unroll
        for (int i = 0; i < 4; ++i) {
            const int c0 = (lane + 64 * i) * 8;
            const f32x4 ga = *(const f32x4*)(g + c0), gb = *(const f32x4*)(g + c0 + 4), ba = *(const f32x4*)(b + c0), bb = *(const f32x4*)(b + c0 + 4);
            f32x4 y0, y1;
#pragma unroll
            for (int k = 0; k < 4; ++k) { y0[k] = (v[8 * i + k] - mu) * rstd * ga[k] + ba[k]; y1[k] = (v[8 * i + 4 + k] - mu) * rstd * gb[k] + bb[k]; }
            *(f32x4*)(io + (size_t)t * DM + c0) = y0; *(f32x4*)(io + (size_t)t * DM + c0 + 4) = y1;
        }
    }
}

#define XB_TMO      128
#define XB_XCNT(j)  (256  + 64 * (j))
#define XB_XSUB(j)  (1280 + 64 * (j))
#define XB_XGEN(j)  (2304 + 64 * (j))
#define XB_TOP      3328
#define XB_TOPGEN   3392
#define XCD_BAR_WORDS 3456
#define XB_SPIN_CAP (1u << 18)
#define LAS __attribute__((address_space(3)))

__device__ __forceinline__ unsigned xb_ld(unsigned* p)              { return __hip_atomic_load(p, __ATOMIC_RELAXED, __HIP_MEMORY_SCOPE_AGENT); }
__device__ __forceinline__ unsigned xb_add(unsigned* p, unsigned v) { return __hip_atomic_fetch_add(p, v, __ATOMIC_RELAXED, __HIP_MEMORY_SCOPE_AGENT); }
__device__ __forceinline__ unsigned xb_xcc_id() { return (unsigned)__builtin_amdgcn_s_getreg((3 << 11) | 20) & 0xFu; }
#define XB_SPIN(cond, bar) do { unsigned _sp = 0; while (cond) { __builtin_amdgcn_s_sleep(1); \
    if ((++_sp & 255u) == 0u) { if (xb_ld(&(bar)[XB_TMO])) break; if (_sp > XB_SPIN_CAP) { atomicAdd(&(bar)[XB_TMO], 1u); break; } } } } while (0)

struct XcdBarrier {
    unsigned* bar; unsigned x;
    volatile LAS unsigned* st;
};

__device__ __forceinline__ XcdBarrier xcd_barrier_post(unsigned* bar, volatile LAS unsigned* st) {
    XcdBarrier b; b.bar = bar; b.x = xb_xcc_id(); b.st = st;
    if (threadIdx.x == 0) (void)xb_add(&bar[XB_XCNT(b.x)], 1u);
    return b;
}
__device__ __forceinline__ void xcd_barrier_complete(unsigned* bar, unsigned x, unsigned& nloc, unsigned& nx) {
    const unsigned G = gridDim.x * gridDim.y * gridDim.z;
    unsigned sum, cnt, mine, sp = 0u;
    for (;;) {
        sum = 0u; cnt = 0u; mine = 0u;
#pragma unroll
        for (unsigned j = 0; j < 16; ++j) { const unsigned c = xb_ld(&bar[XB_XCNT(j)]); sum += c; cnt += (c > 0u) ? 1u : 0u; mine = (j == x) ? c : mine; }
        if (sum == G) break;
        __builtin_amdgcn_s_sleep(1);
        if ((++sp & 255u) == 0u) { if (xb_ld(&bar[XB_TMO])) break; if (sp > XB_SPIN_CAP) { atomicAdd(&bar[XB_TMO], 1u); break; } }
    }
    nloc = mine > 0u ? mine : 1u; nx = cnt > 0u ? cnt : 1u;
}

__device__ __forceinline__ void xcd_barrier(const XcdBarrier& b) {
    asm volatile("s_waitcnt vmcnt(0)" ::: "memory");
    __syncthreads();
    if (threadIdx.x == 0) {
        unsigned* bar = b.bar;
        __builtin_amdgcn_s_waitcnt(0);
        unsigned nloc = b.st[0], nx = b.st[1];
        if (nloc == 0u) { xcd_barrier_complete(bar, b.x, nloc, nx); b.st[0] = nloc; b.st[1] = nx; }
        const unsigned old = xb_add(&bar[XB_XSUB(b.x)], 1u);
        const unsigned gen = old / nloc;
        if (old + 1u == (gen + 1u) * nloc) {
            __builtin_amdgcn_fence(__ATOMIC_RELEASE, "agent");
            asm volatile("s_waitcnt vmcnt(0)" ::: "memory");
            const unsigned og = xb_add(&bar[XB_TOP], 1u);
            const unsigned tg = og / nx;
            if (og + 1u == (tg + 1u) * nx) xb_add(&bar[XB_TOPGEN], 1u);
            else XB_SPIN(xb_ld(&bar[XB_TOPGEN]) == tg, bar);
            __builtin_amdgcn_fence(__ATOMIC_ACQUIRE, "agent");
            xb_add(&bar[XB_XGEN(b.x)], 1u);
            asm volatile("s_waitcnt vmcnt(0)" ::: "memory");
        } else {
            XB_SPIN(xb_ld(&bar[XB_XGEN(b.x)]) == gen, bar);
            __builtin_amdgcn_fence(__ATOMIC_ACQUIRE, "agent");
            asm volatile("s_waitcnt vmcnt(0)" ::: "memory");
        }
    }
    __syncthreads();
}

__global__ void __launch_bounds__(512) hymba_fwd(Params p) {
    extern __shared__ __attribute__((aligned(16))) unsigned char lds[];
    cg::grid_group grid = cg::this_grid();
    volatile LAS unsigned* bst = (volatile LAS unsigned*)(lds + 131072);
    if (threadIdx.x < 2) bst[threadIdx.x] = 0u;
    __syncthreads();
    const XcdBarrier xbar = xcd_barrier_post((unsigned*)(p.ws + WS_END + 131072), bst);
    const int bid = blockIdx.x, nb = gridDim.x;
    unsigned char* ws = p.ws;
    bf16_t* xb = (bf16_t*)(ws + WS_R0); bf16_t* mix = (bf16_t*)(ws + WS_R2);
    unsigned char* U8 = ws + WS_R0 + 96 * MiB; unsigned char* V8 = ws + WS_R0 + 112 * MiB; float* Us = (float*)(ws + WS_END); float* Vs = Us + 16384;
    bf16_t* Uc = (bf16_t*)(ws + WS_R1); bf16_t* BG = (bf16_t*)(ws + WS_R1 + 48 * MiB); bf16_t* Z = (bf16_t*)(ws + WS_R1);
    bf16_t* KVf = (bf16_t*)(ws + WS_R2); bf16_t* KVb = (bf16_t*)(ws + WS_R2 + 48 * MiB); bf16_t* H = (bf16_t*)(ws + WS_R2);
    bf16_t* Sf = (bf16_t*)(ws + WS_R3); bf16_t* Sb = (bf16_t*)(ws + WS_R3 + 48 * MiB);
    bf16_t* WinT = (bf16_t*)(ws + WS_W); bf16_t* WoutT = (bf16_t*)(ws + WS_W + 28 * MiB); bf16_t* WqkT = (bf16_t*)(ws + WS_W + 36 * MiB);
    bf16_t* Q = (bf16_t*)p.out; bf16_t* K = Q + (size_t)TOK * RW; bf16_t* V = K + (size_t)TOK * RW; bf16_t* G = V + (size_t)TOK * RW;

#ifndef PH_MASK
#define PH_MASK 0xFFFF
#endif
    if (PH_MASK & 1) {
    convert_flat(p.x_prompt, xb, (size_t)8192 * DM / 8, bid, nb);
    convert_flat(p.x_sample, xb + (size_t)8192 * DM, (size_t)16384 * DM / 8, bid, nb);
    transpose_convert<true>(p.w_in, NPROJ, WinT, NPROJ, bid, nb);
    transpose_convert<false>(p.w_out, DM, WoutT, DM, bid, nb);
    fold_phase(p.w_query, p.keys1, p.keys2, WqkT, lds, bid, nb);
    }
    if (p.ws == nullptr) grid.sync();
    xcd_barrier(xbar);
    if (PH_MASK & 2) {
        pg8::Gemm g{xb, WinT, TOK, NPROJ, DM}; pg8::StaticOrder S; S.init(TOK, NPROJ, nb, bid);
        EpiInProj E{Q, Uc, BG};
        pg8::gemm_phase<EpiInProj, pg8::StaticOrder, false>((PG8_LAS unsigned char*)lds, g, S, E, nullptr);
        const int rem = ((TOK / 256) * (NPROJ / 256)) % nb;
        if (rem) { if (bid >= rem) table_fp4_phase(p.peer_u, U8, Us, bid - rem, nb - rem); } else table_fp4_phase(p.peer_u, U8, Us, bid, nb);
    }
    xcd_barrier(xbar);
    if (PH_MASK & 4) r1_phase(K, V, KVf, KVb, p.rate_f, p.rate_b, lds, bid, nb);
    xcd_barrier(xbar);
    if (PH_MASK & 8) r2_phase(KVf, KVb, Sf, Sb, p.rate_f, p.rate_b, bid, nb);
    xcd_barrier(xbar);
    if (PH_MASK & 16) r3_phase(Q, K, V, G, Sf, Sb, p.rate_f, p.rate_b, p.gn_g, mix, lds, bid, nb);
    if (PH_MASK & 32) conv_phase(Uc, BG, p.conv_w, mix, bid, nb);
    xcd_barrier(xbar);
    if (PH_MASK & 64) {
        pg8::Gemm g{mix, WoutT, TOK, DM, DM}; pg8::StaticOrder S; S.init(TOK, DM, nb, bid);
        EpiOutProj E{Z};
        pg8::gemm_phase<EpiOutProj, pg8::StaticOrder, false>((PG8_LAS unsigned char*)lds, g, S, E, nullptr);
    }
    xcd_barrier(xbar);
    if (PH_MASK & 128) ln1_phase(Z, xb, p.ln1_g, p.ln1_b, H, bid, nb);
    table_fp4_phase(p.peer_v, V8, Vs, bid, nb);
    xcd_barrier(xbar);
    if (PH_MASK & 256) {
        pg8::Gemm g{H, WqkT, TOK, DM, DM}; pg8::StaticOrder S; S.init(TOK, DM, nb, bid);
        EpiScore E{p.out};
        pg8::gemm_phase<EpiScore, pg8::StaticOrder, false>((PG8_LAS unsigned char*)lds, g, S, E, nullptr);
    }
    xcd_barrier(xbar);
    {
        int* sel_eid = (int*)(ws + WS_R1); float* sel_gate = (float*)(ws + WS_R1 + 16 * MiB); float* Cf = (float*)(ws + WS_R1 + 32 * MiB);
        route_phase(p.out, sel_eid, sel_gate, lds, bid, nb);
        xcd_barrier(xbar);
        peerA_phase(H, U8, sel_eid, p.out, bid, nb);
        xcd_barrier(xbar);
        peerC_phase(p.out, sel_eid, sel_gate, Us, Vs, Cf, bid, nb);
        xcd_barrier(xbar);
        peerB_phase(V8, sel_eid, Cf, p.out, bid, nb);
        xcd_barrier(xbar);
        ln2_phase(H, p.out, p.ln2_g, p.ln2_b, bid, nb);
    }
}

extern "C" void kernel_launch(void* const* d_in, const int* in_sizes, int n_in, void* d_out, int out_size, void* d_ws, size_t ws_size, hipStream_t stream) {
    constexpr int LDS_BYTES = 131072 + 16;
    static int grid_blocks = 0;
    if (!grid_blocks) {
        int dev = 0, cus = 0, per_cu = 0;
        hipGetDevice(&dev);
        hipDeviceGetAttribute(&cus, hipDeviceAttributeMultiprocessorCount, dev);
        hipFuncSetAttribute((const void*)hymba_fwd, hipFuncAttributeMaxDynamicSharedMemorySize, LDS_BYTES);
        hipOccupancyMaxActiveBlocksPerMultiprocessor(&per_cu, (const void*)hymba_fwd, 512, LDS_BYTES);
        if (per_cu < 1) per_cu = 1;
        grid_blocks = cus * per_cu;
        if (ws_size < WS_END + 131072 + XCD_BAR_WORDS * 4) fprintf(stderr, "kernel_launch: workspace too small: %zu < %zu\n", ws_size, (size_t)WS_END);
    }
    (void)hipMemsetAsync((unsigned char*)d_ws + WS_END + 131072, 0, XCD_BAR_WORDS * 4, stream);
    Params p{};
    const float** pp = (const float**)&p;
    for (int i = 0; i < 17; ++i) pp[i] = (const float*)d_in[i];
    p.out = (float*)d_out; p.ws = (unsigned char*)d_ws;
    void* args[] = {&p};
    hipError_t e = hipLaunchCooperativeKernel((const void*)hymba_fwd, dim3(grid_blocks), dim3(512), args, LDS_BYTES, stream);
    if (e != hipSuccess) fprintf(stderr, "cooperative launch failed: %s (grid %d)\n", hipGetErrorString(e), grid_blocks);
}
```

```cpp
#include <hip/hip_runtime.h>
#include <hip/hip_cooperative_groups.h>
#include <cstdio>
namespace cg = cooperative_groups;
namespace pg8 {
#define PG8_LAS __attribute__((address_space(3)))
typedef unsigned short bf16_t;
typedef short bf16x8 __attribute__((ext_vector_type(8)));
typedef float f32x4 __attribute__((ext_vector_type(4)));
typedef unsigned u32x4 __attribute__((ext_vector_type(4)));
constexpr int BM = 256, BK = 64, HALF = 128, HTB = HALF * BK * 2  , STAGE_BYTES = 8 * HTB, NXCD = 8, WGM = 8;

__host__ __device__ __forceinline__ int lds_byte(int r, int c) { const int st = (r >> 4) * 2 + (c >> 5), rr = r & 15, cc = c & 31, ob = rr * 64 + cc * 2; return st * 1024 + (ob ^ (((ob >> 9) & 1) << 5)); }
__host__ __device__ __forceinline__ void stage_rc(int b, int& R, int& C) { const int st = b / 1024, sb = b % 1024, swz = sb ^ (((sb >> 9) & 1) << 5); R = (st >> 1) * 16 + swz / 64; C = (st & 1) * 32 + (swz % 64) / 2; }
__host__ __device__ __forceinline__ int perm32(int rho) { const int n = rho >> 4, i = rho & 15; return 8 * (i >> 2) + 4 * n + (i & 3); }

struct Unit { int pm, pn; };
struct Gemm { const bf16_t* A; const bf16_t* Bt; int M, N, K; };

struct StaticOrder {
    int nM, nN, nwg, G, c;
    __host__ __device__ void init(int M, int N, int G_, int c_) { nM = M / BM; nN = N / BM; nwg = nM * nN; G = G_; c = c_; }
    __host__ __device__ bool next(int i, Unit& u) const {
        const long L = (long)i * G + c; if (L >= nwg) return false;
        int wgid = (int)L; { const int q = nwg / NXCD, r = nwg % NXCD, xcd = wgid % NXCD, off = wgid / NXCD; wgid = (xcd < r ? xcd * (q + 1) : r * (q + 1) + (xcd - r) * q) + off; }
        const int nig = WGM * nN, gid = wgid / nig, fm = gid * WGM, gsz = (nM - fm) < WGM ? (nM - fm) : WGM;
        u.pm = fm + ((wgid % nig) % gsz); u.pn = (wgid % nig) / gsz; return true;
    }
    __device__ __forceinline__ void a_ready(const Unit&) const {}
    __device__ __forceinline__ void done(const Unit&) const {}
};
template <class Epi, class Sched, bool STAMP = false>
__device__ __forceinline__ void gemm_phase(PG8_LAS unsigned char* lds, const Gemm g, const Sched& S, const Epi& E, unsigned long long* stamps) {
    const int tid = threadIdx.x, wid = __builtin_amdgcn_readfirstlane(tid >> 6), lane = tid & 63, wr = wid >> 2, wc = wid & 3, fr = lane & 15, fq = lane >> 4;
    const int K = g.K, nt = K / BK;
    int ts_lo = 0, ts_hi = 0, nts = 0; const unsigned long long rt_entry = STAMP ? (unsigned long long)wall_clock64() : 0ull;
#define PG8_STAMP() do { if (STAMP && wid == 0 && nts < 64) { const unsigned long long _c = (unsigned long long)clock64(); \
        ts_lo = (lane == nts) ? (int)(unsigned)_c : ts_lo; ts_hi = (lane == nts) ? (int)(unsigned)(_c >> 32) : ts_hi; ++nts; } } while (0)
    PG8_STAMP();
    unsigned voffA[2], voffB[2];
#pragma unroll
    for (int i = 0; i < 2; ++i) { int R, C; stage_rc(tid * 16 + i * 8192, R, C); const int Rb = Epi::PERM ? ((R & ~31) + perm32(R & 31)) : R;
        voffA[i] = (unsigned)(R * K + C) * 2u; voffB[i] = (unsigned)(Rb * K + C) * 2u; }
    const size_t kstep = (size_t)(BK * 2);
    const size_t hstep = (size_t)HALF * K * 2;
    const size_t tstep = 2 * hstep;
    const unsigned ldsw = (unsigned)wid * 1024u;
    const int aoff = lds_byte(wr * 64 + fr, fq * 8), boff = lds_byte(wc * 32 + fr, fq * 8);
#define PG8_SA(b, h) (((b) * 2 + (h)) * HTB)
#define PG8_SB(b, h) ((4 + (b) * 2 + (h)) * HTB)
#define PG8_STAGE(bufoff, gbase, voff) do { _Pragma("unroll") for (int _i = 0; _i < 2; ++_i) \
        __builtin_amdgcn_global_load_lds((const unsigned*)((const char*)(gbase) + (voff)[_i]), (PG8_LAS unsigned*)(lds + (bufoff) + ldsw + _i * 8192), 16, 0, 0); } while (0)
#define PG8_LDA(dst, b, h) do { _Pragma("unroll") for (int m = 0; m < 4; ++m) _Pragma("unroll") for (int k = 0; k < 2; ++k) dst[m][k] = *(const PG8_LAS bf16x8*)(lds + PG8_SA(b, h) + aoff + m * 2048 + k * 1024); } while (0)
#define PG8_LDB(dst, b, h) do { _Pragma("unroll") for (int n = 0; n < 2; ++n) _Pragma("unroll") for (int k = 0; k < 2; ++k) dst[n][k] = *(const PG8_LAS bf16x8*)(lds + PG8_SB(b, h) + boff + n * 2048 + k * 1024); } while (0)
#define PG8_MMA(ai, bj, At, Bt) do { __builtin_amdgcn_s_setprio(1); _Pragma("unroll") for (int m = 0; m < 4; ++m) _Pragma("unroll") for (int n = 0; n < 2; ++n) _Pragma("unroll") for (int k = 0; k < 2; ++k) \
        acc[ai][bj][m][n] = __builtin_amdgcn_mfma_f32_16x16x32_bf16(Bt[n][k], At[m][k], acc[ai][bj][m][n], 0, 0, 0); __builtin_amdgcn_s_setprio(0); } while (0)
#define PG8_WAIT_V(n) asm volatile("s_waitcnt vmcnt(" #n ")" ::: "memory")
#define PG8_WAIT_L(n) asm volatile("s_waitcnt lgkmcnt(" #n ")" ::: "memory")
#define PG8_BAR __builtin_amdgcn_s_barrier()
#define PG8_SCHED __builtin_amdgcn_sched_barrier(0)
    Unit cur, nxt; int ui = 0;
    if (!S.next(0, cur)) return;
    f32x4 acc[2][2][4][2];
#pragma unroll
    for (int a = 0; a < 2; ++a)
#pragma unroll
        for (int b = 0; b < 2; ++b)
#pragma unroll
            for (int m = 0; m < 4; ++m)
#pragma unroll
                for (int n = 0; n < 2; ++n) acc[a][b][m][n] = (f32x4){0.f, 0.f, 0.f, 0.f};
    bf16x8 At[4][2], B0[2][2], B1[2][2];
    const char* cA = (const char*)g.A + (size_t)cur.pm * tstep; const char* cB = (const char*)g.Bt + (size_t)cur.pn * tstep;
    S.a_ready(cur);
    PG8_STAGE(PG8_SB(0, 0), cB, voffB); PG8_STAGE(PG8_SA(0, 0), cA, voffA); PG8_STAGE(PG8_SB(0, 1), cB + hstep, voffB); PG8_STAGE(PG8_SA(0, 1), cA + hstep, voffA);
    if (wr == 1) PG8_BAR;
    PG8_WAIT_V(4); PG8_BAR;
    PG8_STAGE(PG8_SB(1, 0), cB + kstep, voffB); PG8_STAGE(PG8_SA(1, 0), cA + kstep, voffA); PG8_STAGE(PG8_SB(1, 1), cB + hstep + kstep, voffB);
    PG8_WAIT_V(6); PG8_BAR;
    PG8_STAMP();
    for (;;) {
        const bool has_next = S.next(ui + 1, nxt);
        const char* nA = has_next ? (const char*)g.A + (size_t)nxt.pm * tstep : cA; const char* nB = has_next ? (const char*)g.Bt + (size_t)nxt.pn * tstep : cB;
        for (int t = 0; t < nt; t += 2) {
            const bool last = (t == nt - 2);
            const char* a1 = cA + (size_t)(t + 1) * kstep;
            const char* a2 = last ? nA : cA + (size_t)(t + 2) * kstep; const char* b2 = last ? nB : cB + (size_t)(t + 2) * kstep;
            const char* a3 = a2 + kstep; const char* b3 = b2 + kstep;
            if (last && has_next) S.a_ready(nxt);
            PG8_LDB(B0, 0, 0); PG8_SCHED; PG8_LDA(At, 0, 0); PG8_STAGE(PG8_SA(1, 1), a1 + hstep, voffA);
            PG8_WAIT_L(8); PG8_BAR; PG8_WAIT_L(0); PG8_MMA(0, 0, At, B0); PG8_BAR; PG8_SCHED;
            PG8_LDB(B1, 0, 1); PG8_STAGE(PG8_SB(0, 0), b2, voffB);
            PG8_BAR; PG8_WAIT_L(0); PG8_MMA(0, 1, At, B1); PG8_BAR;
            PG8_LDA(At, 0, 1); PG8_STAGE(PG8_SA(0, 0), a2, voffA);
            PG8_BAR; PG8_WAIT_L(0); PG8_MMA(1, 0, At, B0); PG8_BAR; PG8_SCHED;
            PG8_STAGE(PG8_SB(0, 1), b2 + hstep, voffB);
            PG8_WAIT_V(6); PG8_BAR; PG8_MMA(1, 1, At, B1); PG8_BAR;
            PG8_LDB(B0, 1, 0); PG8_SCHED; PG8_LDA(At, 1, 0); PG8_STAGE(PG8_SA(0, 1), a2 + hstep, voffA);
            PG8_WAIT_L(8); PG8_BAR; PG8_WAIT_L(0); PG8_MMA(0, 0, At, B0); PG8_BAR; PG8_SCHED;
            PG8_LDB(B1, 1, 1); PG8_STAGE(PG8_SB(1, 0), b3, voffB);
            PG8_BAR; PG8_WAIT_L(0); PG8_MMA(0, 1, At, B1); PG8_BAR;
            PG8_LDA(At, 1, 1); PG8_STAGE(PG8_SA(1, 0), a3, voffA);
            PG8_BAR; PG8_WAIT_L(0); PG8_MMA(1, 0, At, B0); PG8_BAR; PG8_SCHED;
            PG8_STAGE(PG8_SB(1, 1), b3 + hstep, voffB);
            PG8_WAIT_V(6); PG8_BAR; PG8_MMA(1, 1, At, B1); PG8_BAR;
        }
        PG8_STAMP();
        if constexpr (!Epi::AFTER_DRAIN) { E(acc, cur, wr, wc, fr, fq); S.done(cur); }
        PG8_STAMP();
        if (!has_next) break;
#pragma unroll
        for (int a = 0; a < 2; ++a)
#pragma unroll
            for (int b = 0; b < 2; ++b)
#pragma unroll
                for (int m = 0; m < 4; ++m)
#pragma unroll
                    for (int n = 0; n < 2; ++n) acc[a][b][m][n] = (f32x4){0.f, 0.f, 0.f, 0.f};
        cur = nxt; cA = nA; cB = nB; ++ui;
    }
    PG8_WAIT_V(0);
    if (wr == 0) PG8_BAR;
    PG8_BAR;
    if constexpr (Epi::AFTER_DRAIN) { E.fused(acc, cur, wr, wc, fr, fq, lds, wid, lane); S.done(cur); }
    PG8_STAMP();
    if (STAMP && wid == 0) { stamps[lane] = lane < nts ? (((unsigned long long)(unsigned)ts_hi << 32) | (unsigned)ts_lo) : 0ull;
        if (lane == 62) stamps[62] = rt_entry; if (lane == 63) stamps[63] = (unsigned long long)wall_clock64(); }
#undef PG8_STAMP
#undef PG8_SA
#undef PG8_SB
#undef PG8_STAGE
#undef PG8_LDA
#undef PG8_LDB
#undef PG8_MMA
#undef PG8_WAIT_V
#undef PG8_WAIT_L
#undef PG8_BAR
#undef PG8_SCHED
}
}

using pg8::bf16_t; using pg8::bf16x8; using pg8::f32x4; using pg8::u32x4;
typedef unsigned u32x2 __attribute__((ext_vector_type(2)));
typedef __bf16 bf16x2_t __attribute__((ext_vector_type(2)));
typedef float f32x2_t __attribute__((ext_vector_type(2)));
#define DI __device__ __forceinline__

constexpr int TOK = 24576, DM = 2048, NPROJ = 7168, RW = 1024;
constexpr float ALPHA = 1.189207115002721f;
constexpr float LOG2E = 1.4426950408889634f;
constexpr size_t MiB = 1048576;
constexpr size_t WS_R0 = 0;
constexpr size_t WS_R1 = 128 * MiB;
constexpr size_t WS_R2 = 224 * MiB;
constexpr size_t WS_R3 = 320 * MiB;
constexpr size_t WS_W  = 416 * MiB;
constexpr size_t WS_END = 460 * MiB;

struct Params {
    const float *x_prompt, *x_sample, *w_in, *rate_f, *rate_b, *gn_g, *conv_w, *w_out, *ln1_g, *ln1_b, *w_query, *keys1, *keys2, *peer_u, *peer_v, *ln2_g, *ln2_b;
    float* out; unsigned char* ws;
};

DI unsigned pk2(float a, float b) { f32x2_t v = {a, b}; return __builtin_bit_cast(unsigned, __builtin_convertvector(v, bf16x2_t)); }
DI float bf_lo(unsigned w) { return __uint_as_float(w << 16); }
DI float bf_hi(unsigned w) { return __uint_as_float(w & 0xffff0000u); }
DI f32x4 mfma16(bf16x8 a, bf16x8 b, f32x4 c) { return __builtin_amdgcn_mfma_f32_16x16x32_bf16(a, b, c, 0, 0, 0); }
DI float wave_sum(float x) { x += __shfl_xor(x, 1); x += __shfl_xor(x, 2); x += __shfl_xor(x, 4); x += __shfl_xor(x, 8); x += __shfl_xor(x, 16); x += __shfl_xor(x, 32); return x; }
DI float dot2bf(unsigned a, unsigned b, float c) { return __builtin_amdgcn_fdot2_f32_bf16(__builtin_bit_cast(bf16x2_t, a), __builtin_bit_cast(bf16x2_t, b), c, false); }
DI const float* xrow(const Params& p, int tok) { return tok < 8192 ? p.x_prompt + (size_t)tok * DM : p.x_sample + (size_t)(tok - 8192) * DM; }

DI int map_inproj(int c) {
    if (c < 2048) { const int blk = c >> 7, cc = c & 127, g = cc >> 3, j = cc & 7; return blk * 128 + 4 * g + (j & 3) + 64 * (j >> 2); }
    if (c < 4096) return c;
    if (c < 6144) { const int t = (c - 4096) >> 8, wi = (c - 4096) & 255, half = wi >> 7, col = wi & 127; return (half ? 6144 : 4096) + 128 * t + col; }
    return 5120 + (c - 6144);
}
template <bool MAPPED> DI void transpose_convert(const float* __restrict__ src, int ld, bf16_t* __restrict__ dst, int N, int bid, int nb) {
    const int lane = threadIdx.x & 63, w = threadIdx.x >> 6, nch = N / 256;
    for (int it = bid; it < nch * 32; it += nb) {
        const int chi = it % nch, k8hi = it / nch, c = chi * 256 + lane * 4, k8 = k8hi * 8 + w;
        const int sc = MAPPED ? map_inproj(c) : c;
        const float* sp = src + (size_t)(k8 * 8) * ld + sc;
        f32x4 v[8];
#pragma unroll
        for (int i = 0; i < 8; ++i) v[i] = *(const f32x4*)(sp + (size_t)i * ld);
#pragma unroll
        for (int cc = 0; cc < 4; ++cc) {
            u32x4 o; o.x = pk2(v[0][cc], v[1][cc]); o.y = pk2(v[2][cc], v[3][cc]); o.z = pk2(v[4][cc], v[5][cc]); o.w = pk2(v[6][cc], v[7][cc]);
            *(u32x4*)(dst + (size_t)(c + cc) * 2048 + k8 * 8) = o;
        }
    }
}
DI void convert_flat(const float* __restrict__ src, bf16_t* __restrict__ dst, size_t n8, int bid, int nb) {
    for (size_t i = (size_t)bid * 512 + threadIdx.x; i < n8; i += (size_t)nb * 512) {
        const float4 a = *(const float4*)(src + i * 8), b = *(const float4*)(src + i * 8 + 4);
        u32x4 o; o.x = pk2(a.x, a.y); o.y = pk2(a.z, a.w); o.z = pk2(b.x, b.y); o.w = pk2(b.z, b.w);
        *(u32x4*)(dst + i * 8) = o;
    }
}
DI void fold_phase(const float* __restrict__ wq, const float* __restrict__ k1, const float* __restrict__ k2, bf16_t* __restrict__ WqkT, unsigned char* lds, int bid, int nb) {
    float* sK = (float*)lds; float* sW = sK + 128 * 132;
    const int tid = threadIdx.x;
    for (int it = bid; it < 512; it += nb) {
        const int hh = it >> 5, kt = it & 31, head = hh >> 1, half = hh & 1;
        const float* keys = (half ? k2 : k1) + (size_t)head * 16384;
        __syncthreads();
        for (int p = tid; p < 4096; p += 512) { const int n = p >> 5, d4 = p & 31; *(float4*)(sK + n * 132 + d4 * 4) = *(const float4*)(keys + n * 128 + d4 * 4); }
        for (int p = tid; p < 2048; p += 512) { const int kk = p >> 5, d4 = p & 31; *(float4*)(sW + kk * 132 + d4 * 4) = *(const float4*)(wq + (size_t)(kt * 64 + kk) * 2048 + hh * 128 + d4 * 4); }
        __syncthreads();
        const int n = tid & 63, kq = tid >> 6;
        float acc0[8], acc1[8];
#pragma unroll
        for (int i = 0; i < 8; ++i) { acc0[i] = 0.f; acc1[i] = 0.f; }
        for (int d4 = 0; d4 < 32; ++d4) {
            const float4 ka = *(const float4*)(sK + n * 132 + d4 * 4), kb = *(const float4*)(sK + (n + 64) * 132 + d4 * 4);
#pragma unroll
            for (int i = 0; i < 8; ++i) { const float4 wv = *(const float4*)(sW + (kq * 8 + i) * 132 + d4 * 4);
                acc0[i] += ka.x * wv.x + ka.y * wv.y + ka.z * wv.z + ka.w * wv.w; acc1[i] += kb.x * wv.x + kb.y * wv.y + kb.z * wv.z + kb.w * wv.w; }
        }
        bf16_t* dst = WqkT + (size_t)(hh * 128 + n) * 2048 + kt * 64 + kq * 8;
        u32x4 o0, o1; o0.x = pk2(acc0[0], acc0[1]); o0.y = pk2(acc0[2], acc0[3]); o0.z = pk2(acc0[4], acc0[5]); o0.w = pk2(acc0[6], acc0[7]);
        o1.x = pk2(acc1[0], acc1[1]); o1.y = pk2(acc1[2], acc1[3]); o1.z = pk2(acc1[4], acc1[5]); o1.w = pk2(acc1[6], acc1[7]);
        *(u32x4*)dst = o0; *(u32x4*)(dst + (size_t)64 * 2048) = o1;
    }
}

struct EpiInProj {
    static constexpr bool PERM = true, AFTER_DRAIN = false;
    bf16_t *Q, *U, *BG;
    __device__ __forceinline__ void operator()(const f32x4 (&acc)[2][2][4][2], const pg8::Unit& u, int wr, int wc, int fr, int fq) const {
        const int pn = u.pn, row0 = u.pm * 256 + wr * 64 + fr, cl = wc * 32 + 8 * fq;
        if (pn < 8) {
            bf16_t* dst = Q + (size_t)(pn >> 2) * ((size_t)TOK * RW); const float sc = pn < 4 ? 1.0f : 0.08838834764831845f; const int colbase = (pn & 3) * 256 + cl;
            float cf[4];
#pragma unroll
            for (int e = 0; e < 4; ++e) cf[e] = exp2f(-(float)(cl / 2 + e) * 0.20762050593046014f) * 0.15915494309189535f;
#pragma unroll
            for (int ai = 0; ai < 2; ++ai)
#pragma unroll
                for (int m = 0; m < 4; ++m) {
                    const int row = row0 + ai * 128 + m * 16; const float pos = (float)(row & 8191);
                    float cs[4], sn[4];
#pragma unroll
                    for (int e = 0; e < 4; ++e) { const float pp = pos * cf[e], er = fmaf(pos, cf[e], -pp), frv = (pp - floorf(pp)) + er; sn[e] = __builtin_amdgcn_sinf(frv); cs[e] = __builtin_amdgcn_cosf(frv); }
#pragma unroll
                    for (int bj = 0; bj < 2; ++bj) {
                        const f32x4 x1 = acc[ai][bj][m][0], x2 = acc[ai][bj][m][1]; float o1[4], o2[4];
#pragma unroll
                        for (int e = 0; e < 4; ++e) { o1[e] = (x1[e] * cs[e] - x2[e] * sn[e]) * sc; o2[e] = (x1[e] * sn[e] + x2[e] * cs[e]) * sc; }
                        u32x4 w; w.x = pk2(o1[0], o1[1]); w.y = pk2(o1[2], o1[3]); w.z = pk2(o2[0], o2[1]); w.w = pk2(o2[2], o2[3]);
                        *(u32x4*)(dst + (size_t)row * RW + colbase + bj * 128) = w;
                    }
                }
        } else if (pn < 16 || pn >= 24) {
            bf16_t* dst = pn < 16 ? Q + (size_t)(pn >> 2) * ((size_t)TOK * RW) : BG; const int colbase = (pn & 3) * 256 + cl;
#pragma unroll
            for (int ai = 0; ai < 2; ++ai)
#pragma unroll
                for (int m = 0; m < 4; ++m) {
                    const int row = row0 + ai * 128 + m * 16;
#pragma unroll
                    for (int bj = 0; bj < 2; ++bj) {
                        const f32x4 v0 = acc[ai][bj][m][0], v1 = acc[ai][bj][m][1];
                        u32x4 w; w.x = pk2(v0[0], v0[1]); w.y = pk2(v0[2], v0[3]); w.z = pk2(v1[0], v1[1]); w.w = pk2(v1[2], v1[3]);
                        *(u32x4*)(dst + (size_t)row * RW + colbase + bj * 128) = w;
                    }
                }
        } else {
            const int colbase = (pn - 16) * 128 + cl;
#pragma unroll
            for (int ai = 0; ai < 2; ++ai)
#pragma unroll
                for (int m = 0; m < 4; ++m) {
                    const int row = row0 + ai * 128 + m * 16;
                    const f32x4 v0 = acc[ai][0][m][0] * acc[ai][1][m][0], v1 = acc[ai][0][m][1] * acc[ai][1][m][1];
                    u32x4 w; w.x = pk2(v0[0], v0[1]); w.y = pk2(v0[2], v0[3]); w.z = pk2(v1[0], v1[1]); w.w = pk2(v1[2], v1[3]);
                    *(u32x4*)(U + (size_t)row * RW + colbase) = w;
                }
        }
    }
};
struct EpiOutProj {
    static constexpr bool PERM = true, AFTER_DRAIN = false;
    bf16_t* Z;
    __device__ __forceinline__ void operator()(const f32x4 (&acc)[2][2][4][2], const pg8::Unit& u, int wr, int wc, int fr, int fq) const {
        const int row0 = u.pm * 256 + wr * 64 + fr, col0 = u.pn * 256 + wc * 32 + 8 * fq;
#pragma unroll
        for (int ai = 0; ai < 2; ++ai)
#pragma unroll
            for (int m = 0; m < 4; ++m) {
                const int row = row0 + ai * 128 + m * 16;
#pragma unroll
                for (int bj = 0; bj < 2; ++bj) {
                    const f32x4 v0 = acc[ai][bj][m][0], v1 = acc[ai][bj][m][1];
                    u32x4 w; w.x = pk2(v0[0], v0[1]); w.y = pk2(v0[2], v0[3]); w.z = pk2(v1[0], v1[1]); w.w = pk2(v1[2], v1[3]);
                    *(u32x4*)(Z + (size_t)row * DM + col0 + bj * 128) = w;
                }
            }
    }
};
struct EpiScore {
    static constexpr bool PERM = true, AFTER_DRAIN = false;
    bf16_t* C;
    __device__ __forceinline__ void operator()(const f32x4 (&acc)[2][2][4][2], const pg8::Unit& u, int wr, int wc, int fr, int fq) const {
        const int row0 = u.pm * 256 + wr * 64 + fr, col0 = u.pn * 256 + wc * 32 + 8 * fq;
#pragma unroll
        for (int ai = 0; ai < 2; ++ai)
#pragma unroll
            for (int m = 0; m < 4; ++m) {
                const int row = row0 + ai * 128 + m * 16;
#pragma unroll
                for (int bj = 0; bj < 2; ++bj) {
                    const f32x4 v0 = acc[ai][bj][m][0], v1 = acc[ai][bj][m][1];
                    u32x4 w; w.x = pk2(v0[0], v0[1]); w.y = pk2(v0[2], v0[3]); w.z = pk2(v1[0], v1[1]); w.w = pk2(v1[2], v1[3]);
                    *(u32x4*)(C + (size_t)row * DM + col0 + bj * 128) = w;
                }
            }
    }
};

DI unsigned tile_off(int r, int j) { return (unsigned)(r * 256 + ((((j >> 3) ^ (r & 15))) << 4) + (j & 7) * 2); }
template <int E> DI unsigned short bfel(const u32x4& v) { const unsigned w = v[E >> 1]; return (unsigned short)((E & 1) ? (w >> 16) : (w & 0xffffu)); }
template <int E> DI float bfelf(const u32x4& v) { const unsigned w = v[E >> 1]; return (E & 1) ? bf_hi(w) : bf_lo(w); }

DI void r1_phase(const bf16_t* __restrict__ K, const bf16_t* __restrict__ V, bf16_t* __restrict__ KVf, bf16_t* __restrict__ KVb, const float* rate_f, const float* rate_b,
                 unsigned char* lds, int bid, int nb) {
    const int tid = threadIdx.x, lane = tid & 63, w = tid >> 6, m16 = lane & 15, quad = lane >> 4;
    unsigned char* sKf = lds; unsigned char* sKb = lds + 32768; unsigned char* sV = lds + 65536;
    for (int item = bid; item < 1536; item += nb) {
        const int hd = item & 7; const size_t T0 = (size_t)(item >> 3) * 128;
        const float lgf = -__expf(rate_f[hd]) * LOG2E, lgb = -__expf(rate_b[hd]) * LOG2E;
        __syncthreads();
#pragma unroll
        for (int i = 0; i < 2; ++i) {
            const int p = tid + 512 * i, j = (p >> 4) * 2, d8 = p & 15;
            const bf16_t* kp = K + (T0 + j) * RW + hd * 128 + d8 * 8; const bf16_t* vp = V + (T0 + j) * RW + hd * 128 + d8 * 8;
            const u32x4 k0 = *(const u32x4*)kp, k1 = *(const u32x4*)(kp + RW), v0 = *(const u32x4*)vp, v1 = *(const u32x4*)(vp + RW);
            const float zf0 = exp2f(lgf * (float)(127 - j)), zf1 = exp2f(lgf * (float)(126 - j)), zb0 = exp2f(lgb * (float)j), zb1 = exp2f(lgb * (float)(j + 1));
#define R1_EL(E) { const int d = d8 * 8 + E; const unsigned off = tile_off(d, j); const float ka = bfelf<E>(k0), kb = bfelf<E>(k1); \
                *(unsigned*)(sKf + off) = pk2(ka * zf0, kb * zf1); *(unsigned*)(sKb + off) = pk2(ka * zb0, kb * zb1); \
                *(unsigned*)(sV + off) = (unsigned)bfel<E>(v0) | ((unsigned)bfel<E>(v1) << 16); }
            R1_EL(0) R1_EL(1) R1_EL(2) R1_EL(3) R1_EL(4) R1_EL(5) R1_EL(6) R1_EL(7)
#undef R1_EL
        }
        __syncthreads();
        f32x4 af[8], ab[8];
#pragma unroll
        for (int mt = 0; mt < 8; ++mt) { af[mt] = (f32x4){0.f, 0.f, 0.f, 0.f}; ab[mt] = (f32x4){0.f, 0.f, 0.f, 0.f}; }
#pragma unroll
        for (int ks = 0; ks < 4; ++ks) {
            const int vr = 16 * w + m16;
            const bf16x8 bv = *(const bf16x8*)(sV + vr * 256 + ((((4 * ks + quad) ^ (vr & 15))) << 4));
#pragma unroll
            for (int mt = 0; mt < 8; ++mt) {
                const int r = 16 * mt + m16; const unsigned o = r * 256 + ((((4 * ks + quad) ^ (r & 15))) << 4);
                const bf16x8 a_f = *(const bf16x8*)(sKf + o), a_b = *(const bf16x8*)(sKb + o);
                af[mt] = mfma16(a_f, bv, af[mt]); ab[mt] = mfma16(a_b, bv, ab[mt]);
            }
        }
        const size_t ob = (size_t)item * 16384 + (size_t)(16 * w + m16) * 128 + 4 * quad;
#pragma unroll
        for (int mt = 0; mt < 8; ++mt) {
            u32x2 a; a.x = pk2(af[mt][0], af[mt][1]); a.y = pk2(af[mt][2], af[mt][3]); *(u32x2*)(KVf + ob + 16 * mt) = a;
            u32x2 b; b.x = pk2(ab[mt][0], ab[mt][1]); b.y = pk2(ab[mt][2], ab[mt][3]); *(u32x2*)(KVb + ob + 16 * mt) = b;
        }
    }
}

DI void r2_phase(const bf16_t* __restrict__ KVf, const bf16_t* __restrict__ KVb, bf16_t* __restrict__ Sf, bf16_t* __restrict__ Sb, const float* rate_f, const float* rate_b, int bid, int nb) {
    for (int g = bid * 512 + threadIdx.x; g < 98304; g += nb * 512) {
        const int dir = g / 49152, rem = g % 49152, sh = rem >> 11, piece = rem & 2047, s = sh >> 3, hd = sh & 7;
        const float lg = -__expf((dir ? rate_b : rate_f)[hd]) * LOG2E, Gc = exp2f(lg * 128.f);
        const bf16_t* src = dir ? KVb : KVf; bf16_t* dst = dir ? Sb : Sf;
        float st[8];
#pragma unroll
        for (int e = 0; e < 8; ++e) st[e] = 0.f;
        for (int cc = 0; cc < 64; ++cc) {
            const int c = dir ? 63 - cc : cc;
            const size_t off = ((size_t)((s * 64 + c) * 8 + hd)) * 16384 + (size_t)piece * 8;
            const u32x4 kv = *(const u32x4*)(src + off);
            u32x4 o; o.x = pk2(st[0], st[1]); o.y = pk2(st[2], st[3]); o.z = pk2(st[4], st[5]); o.w = pk2(st[6], st[7]);
            *(u32x4*)(dst + off) = o;
            st[0] = st[0] * Gc + bf_lo(kv.x); st[1] = st[1] * Gc + bf_hi(kv.x); st[2] = st[2] * Gc + bf_lo(kv.y); st[3] = st[3] * Gc + bf_hi(kv.y);
            st[4] = st[4] * Gc + bf_lo(kv.z); st[5] = st[5] * Gc + bf_hi(kv.z); st[6] = st[6] * Gc + bf_lo(kv.w); st[7] = st[7] * Gc + bf_hi(kv.w);
        }
    }
}

DI float silu_f(float x) { return x * __builtin_amdgcn_rcpf(1.0f + __builtin_amdgcn_exp2f(-x * LOG2E)); }

DI void r3_phase(const bf16_t* __restrict__ Q, const bf16_t* __restrict__ K, const bf16_t* __restrict__ V, const bf16_t* __restrict__ G, const bf16_t* __restrict__ Sf, const bf16_t* __restrict__ Sb,
                 const float* rate_f, const float* rate_b, const float* __restrict__ gn_g, bf16_t* __restrict__ mix, unsigned char* lds, int bid, int nb) {
    const int tid = threadIdx.x, lane = tid & 63, w = tid >> 6, m16 = lane & 15, quad = lane >> 4;
    unsigned char* sV = lds; unsigned char* sK = lds + 32768; unsigned char* sSf = lds + 65536; unsigned char* sSb = lds + 98304;
    for (int item = bid; item < 1536; item += nb) {
        const int hd = item & 7; const size_t T0 = (size_t)(item >> 3) * 128;
        const float lgf = -__expf(rate_f[hd]) * LOG2E, lgb = -__expf(rate_b[hd]) * LOG2E;
        __syncthreads();
#pragma unroll
        for (int i = 0; i < 4; ++i) {
            const int p = tid + 512 * i, r = p >> 4, c16 = p & 15;
            const unsigned o = (unsigned)(r * 256 + ((c16 ^ (r & 15)) << 4));
            *(u32x4*)(sK + o) = *(const u32x4*)(K + (T0 + r) * RW + hd * 128 + c16 * 8);
            *(u32x4*)(sSf + o) = *(const u32x4*)(Sf + (size_t)item * 16384 + r * 128 + c16 * 8);
            *(u32x4*)(sSb + o) = *(const u32x4*)(Sb + (size_t)item * 16384 + r * 128 + c16 * 8);
        }
#pragma unroll
        for (int i = 0; i < 2; ++i) {
            const int p = tid + 512 * i, j = (p >> 4) * 2, d8 = p & 15;
            const bf16_t* vp = V + (T0 + j) * RW + hd * 128 + d8 * 8;
            const u32x4 v0 = *(const u32x4*)vp, v1 = *(const u32x4*)(vp + RW);
#define R3_EL(E) { *(unsigned*)(sV + tile_off(d8 * 8 + E, j)) = (unsigned)bfel<E>(v0) | ((unsigned)bfel<E>(v1) << 16); }
            R3_EL(0) R3_EL(1) R3_EL(2) R3_EL(3) R3_EL(4) R3_EL(5) R3_EL(6) R3_EL(7)
#undef R3_EL
        }
        const int il = 16 * w + m16;
        const size_t tq = T0 + il;
        bf16x8 bq[4];
#pragma unroll
        for (int ks = 0; ks < 4; ++ks) bq[ks] = *(const bf16x8*)(Q + tq * RW + hd * 128 + 32 * ks + 8 * quad);
        __syncthreads();
        f32x4 aS[8];
#pragma unroll
        for (int mt = 0; mt < 8; ++mt) aS[mt] = (f32x4){0.f, 0.f, 0.f, 0.f};
#pragma unroll
        for (int ks = 0; ks < 4; ++ks)
#pragma unroll
            for (int mt = 0; mt < 8; ++mt) {
                const int r = 16 * mt + m16;
                const bf16x8 ak = *(const bf16x8*)(sK + r * 256 + ((((4 * ks + quad) ^ (r & 15))) << 4));
                aS[mt] = mfma16(ak, bq[ks], aS[mt]);
            }
        bf16x8 bp[4];
#pragma unroll
        for (int s = 0; s < 4; ++s) {
            float pv[8];
#pragma unroll
            for (int t = 0; t < 8; ++t) {
                const int mt = 2 * s + (t >> 2), r = t & 3, j = 16 * mt + 4 * quad + r, dl = il - j;
                const float dec = dl > 0 ? __builtin_amdgcn_exp2f(lgf * (float)dl) : (dl < 0 ? __builtin_amdgcn_exp2f(lgb * (float)(-dl)) : 2.0f);
                pv[t] = aS[mt][r] * dec;
            }
            u32x4 pk; pk.x = pk2(pv[0], pv[1]); pk.y = pk2(pv[2], pv[3]); pk.z = pk2(pv[4], pv[5]); pk.w = pk2(pv[6], pv[7]);
            bp[s] = __builtin_bit_cast(bf16x8, pk);
        }
        f32x4 aO[8];
#pragma unroll
        for (int mt = 0; mt < 8; ++mt) aO[mt] = (f32x4){0.f, 0.f, 0.f, 0.f};
#pragma unroll
        for (int s = 0; s < 4; ++s)
#pragma unroll
            for (int mt = 0; mt < 8; ++mt) {
                const int row = 16 * mt + m16;
                const u32x2 lo = *(const u32x2*)(sV + row * 256 + ((((4 * s + (quad >> 1)) ^ (row & 15))) << 4) + (quad & 1) * 8);
                const u32x2 hi = *(const u32x2*)(sV + row * 256 + ((((4 * s + 2 + (quad >> 1)) ^ (row & 15))) << 4) + (quad & 1) * 8);
                u32x4 av; av.x = lo.x; av.y = lo.y; av.z = hi.x; av.w = hi.y;
                aO[mt] = mfma16(__builtin_bit_cast(bf16x8, av), bp[s], aO[mt]);
            }
#pragma unroll
        for (int dir = 0; dir < 2; ++dir) {
            const unsigned char* sS = dir ? sSb : sSf;
            f32x4 aX[8];
#pragma unroll
            for (int mt = 0; mt < 8; ++mt) aX[mt] = (f32x4){0.f, 0.f, 0.f, 0.f};
#pragma unroll
            for (int ks = 0; ks < 4; ++ks)
#pragma unroll
                for (int mt = 0; mt < 8; ++mt) {
                    const int r = 16 * mt + m16;
                    const bf16x8 a = *(const bf16x8*)(sS + r * 256 + ((((4 * ks + quad) ^ (r & 15))) << 4));
                    aX[mt] = mfma16(a, bq[ks], aX[mt]);
                }
            const float xi = dir ? exp2f(lgb * (float)(128 - il)) : exp2f(lgf * (float)(il + 1));
#pragma unroll
            for (int mt = 0; mt < 8; ++mt) aO[mt] += xi * aX[mt];
        }
        float sum = 0.f;
#pragma unroll
        for (int mt = 0; mt < 8; ++mt) sum += (aO[mt][0] + aO[mt][1]) + (aO[mt][2] + aO[mt][3]);
        sum += __shfl_xor(sum, 16); sum += __shfl_xor(sum, 32);
        const float mu = sum * (1.0f / 128.0f); float qv = 0.f;
#pragma unroll
        for (int mt = 0; mt < 8; ++mt) { const f32x4 d = aO[mt] - mu; qv += (d[0] * d[0] + d[1] * d[1]) + (d[2] * d[2] + d[3] * d[3]); }
        qv += __shfl_xor(qv, 16); qv += __shfl_xor(qv, 32);
        const float rstd = rsqrtf(qv * (1.0f / 128.0f) + 1e-6f);
#pragma unroll
        for (int mt = 0; mt < 8; ++mt) {
            const int dv0 = 16 * mt + 4 * quad;
            const u32x2 gg = *(const u32x2*)(G + tq * RW + hd * 128 + dv0); const f32x4 gn = *(const f32x4*)(gn_g + hd * 128 + dv0);
            const float o0 = (aO[mt][0] - mu) * rstd * gn[0] * silu_f(bf_lo(gg.x)), o1 = (aO[mt][1] - mu) * rstd * gn[1] * silu_f(bf_hi(gg.x));
            const float o2 = (aO[mt][2] - mu) * rstd * gn[2] * silu_f(bf_lo(gg.y)), o3 = (aO[mt][3] - mu) * rstd * gn[3] * silu_f(bf_hi(gg.y));
            u32x2 o; o.x = pk2(o0, o1); o.y = pk2(o2, o3);
            *(u32x2*)(mix + tq * DM + hd * 128 + dv0) = o;
        }
    }
}

DI void conv_phase(const bf16_t* __restrict__ U, const bf16_t* __restrict__ BG, const float* __restrict__ cw, bf16_t* __restrict__ mix, int bid, int nb) {
    for (size_t i = (size_t)bid * 512 + threadIdx.x; i < (size_t)TOK * 128; i += (size_t)nb * 512) {
        const size_t t = i >> 7; const int c8 = (int)(i & 127) * 8, pos = (int)(t & 8191);
        const u32x4 zero = {0u, 0u, 0u, 0u};
        const u32x4 u1 = *(const u32x4*)(U + t * RW + c8);
        const u32x4 u0 = pos > 0 ? *(const u32x4*)(U + (t - 1) * RW + c8) : zero;
        const u32x4 u2 = pos < 8191 ? *(const u32x4*)(U + (t + 1) * RW + c8) : zero;
        const u32x4 bg = *(const u32x4*)(BG + t * RW + c8);
        const f32x4 w0a = *(const f32x4*)(cw + c8), w0b = *(const f32x4*)(cw + c8 + 4), w1a = *(const f32x4*)(cw + 1024 + c8), w1b = *(const f32x4*)(cw + 1024 + c8 + 4),
                    w2a = *(const f32x4*)(cw + 2048 + c8), w2b = *(const f32x4*)(cw + 2048 + c8 + 4);
        float r[8];
#define CV(E, WA, IDX) r[E] = bfelf<E>(bg) * (WA##0[IDX] * bfelf<E>(u0) + WA##1[IDX] * bfelf<E>(u1) + WA##2[IDX] * bfelf<E>(u2));
        { const f32x4 A0 = w0a, A1 = w1a, A2 = w2a, B0 = w0b, B1 = w1b, B2 = w2b;
          CV(0, A, 0) CV(1, A, 1) CV(2, A, 2) CV(3, A, 3) CV(4, B, 0) CV(5, B, 1) CV(6, B, 2) CV(7, B, 3) }
#undef CV
        u32x4 o; o.x = pk2(r[0], r[1]); o.y = pk2(r[2], r[3]); o.z = pk2(r[4], r[5]); o.w = pk2(r[6], r[7]);
        *(u32x4*)(mix + t * DM + 1024 + c8) = o;
    }
}

DI void ln1_phase(const bf16_t* __restrict__ Z, const bf16_t* __restrict__ X, const float* __restrict__ g, const float* __restrict__ b, bf16_t* __restrict__ H, int bid, int nb) {
    const int lane = threadIdx.x & 63, w = threadIdx.x >> 6;
    for (int row = bid * 8 + w; row < TOK; row += nb * 8) {
        u32x4 zv[4], xv[4]; float v[32];
#pragma unroll
        for (int i = 0; i < 4; ++i) { zv[i] = *(const u32x4*)(Z + (size_t)row * DM + (lane + 64 * i) * 8); xv[i] = *(const u32x4*)(X + (size_t)row * DM + (lane + 64 * i) * 8); }
        float s = 0.f;
#pragma unroll
        for (int i = 0; i < 4; ++i)
#pragma unroll
            for (int k = 0; k < 4; ++k) { v[8 * i + 2 * k] = bf_lo(zv[i][k]) + ALPHA * bf_lo(xv[i][k]); v[8 * i + 2 * k + 1] = bf_hi(zv[i][k]) + ALPHA * bf_hi(xv[i][k]); s += v[8 * i + 2 * k] + v[8 * i + 2 * k + 1]; }
        s = wave_sum(s); const float mu = s * (1.0f / 2048.0f); float q = 0.f;
#pragma unroll
        for (int k = 0; k < 32; ++k) { const float d = v[k] - mu; q += d * d; }
        q = wave_sum(q); const float rstd = rsqrtf(q * (1.0f / 2048.0f) + 1e-5f);
#pragma unroll
        for (int i = 0; i < 4; ++i) {
            const int c0 = (lane + 64 * i) * 8;
            const f32x4 ga = *(const f32x4*)(g + c0), gb = *(const f32x4*)(g + c0 + 4), ba = *(const f32x4*)(b + c0), bb = *(const f32x4*)(b + c0 + 4);
            u32x4 o;
            o.x = pk2((v[8 * i + 0] - mu) * rstd * ga[0] + ba[0], (v[8 * i + 1] - mu) * rstd * ga[1] + ba[1]);
            o.y = pk2((v[8 * i + 2] - mu) * rstd * ga[2] + ba[2], (v[8 * i + 3] - mu) * rstd * ga[3] + ba[3]);
            o.z = pk2((v[8 * i + 4] - mu) * rstd * gb[0] + bb[0], (v[8 * i + 5] - mu) * rstd * gb[1] + bb[1]);
            o.w = pk2((v[8 * i + 6] - mu) * rstd * gb[2] + bb[2], (v[8 * i + 7] - mu) * rstd * gb[3] + bb[3]);
            *(u32x4*)(H + (size_t)row * DM + c0) = o;
        }
    }
}


DI void table_fp4_phase(const float* __restrict__ src, unsigned char* __restrict__ dst, float* __restrict__ scale, int bid, int nb, int row_begin = 0, int row_end = 16384) {
    const int lane = threadIdx.x & 63, w = threadIdx.x >> 6;
    for (int row = row_begin + bid * 8 + w; row < row_end; row += nb * 8) {
        f32x4 v[8]; float am = 0.f;
#pragma unroll
        for (int k = 0; k < 8; ++k) { v[k] = *(const f32x4*)(src + (size_t)row * DM + lane * 32 + 4 * k);
            am = fmaxf(am, fmaxf(fmaxf(fabsf(v[k][0]), fabsf(v[k][1])), fmaxf(fabsf(v[k][2]), fabsf(v[k][3])))); }
        am = fmaxf(am, __shfl_xor(am, 1)); am = fmaxf(am, __shfl_xor(am, 2)); am = fmaxf(am, __shfl_xor(am, 4)); am = fmaxf(am, __shfl_xor(am, 8)); am = fmaxf(am, __shfl_xor(am, 16)); am = fmaxf(am, __shfl_xor(am, 32));
        const float sc = am > 0.f ? am * (0.8f / 6.0f) : 1.0f, inv = 1.0f / sc;
        if (lane == 0) scale[row] = sc;
        u32x4 o;
#pragma unroll
        for (int k = 0; k < 4; ++k) {
            unsigned wd = 0;
            wd = __builtin_amdgcn_cvt_scalef32_pk_fp4_f32(wd, v[2 * k][0] * inv, v[2 * k][1] * inv, 1.0f, 0);
            wd = __builtin_amdgcn_cvt_scalef32_pk_fp4_f32(wd, v[2 * k][2] * inv, v[2 * k][3] * inv, 1.0f, 1);
            wd = __builtin_amdgcn_cvt_scalef32_pk_fp4_f32(wd, v[2 * k + 1][0] * inv, v[2 * k + 1][1] * inv, 1.0f, 2);
            wd = __builtin_amdgcn_cvt_scalef32_pk_fp4_f32(wd, v[2 * k + 1][2] * inv, v[2 * k + 1][3] * inv, 1.0f, 3);
            o[k] = wd;
        }
        *(u32x4*)(dst + ((size_t)(lane >> 3) * 16384 + row) * 128 + (lane & 7) * 16) = o;
    }
}

#define INS16(r, x) { _Pragma("unroll") for (int j_ = 15; j_ >= 1; --j_) r[j_] = __builtin_amdgcn_fmed3f(r[j_ - 1], r[j_], x); r[0] = fmaxf(r[0], x); }
DI float gelu_f(float x) { return 0.5f * x * (1.0f + erff(x * 0.7071067811865476f)); }


DI void route_phase(const float* __restrict__ scores, int* __restrict__ sel_eid, float* __restrict__ sel_gate, unsigned char* lds, int bid, int nb) {
    const int full = nb * 512 < TOK * 8 ? nb * 512 : TOK * 8, rest = TOK * 8 - full;
    int pb = rest > 0 ? (rest + nb - 1) / nb : 0; if (pb > 512) pb = 512;
    for (int seg = 0; seg < 2; ++seg)
    for (int row = seg == 0 ? bid * 512 + (int)threadIdx.x : ((int)threadIdx.x < pb ? full + bid * pb + (int)threadIdx.x : TOK * 8); row < (seg == 0 ? full : TOK * 8); row += (seg == 0 ? nb * 512 : nb * pb)) {
        const size_t tok = (size_t)(row >> 3); const int head = row & 7;
        const u32x4* sp = (const u32x4*)((const bf16_t*)scores + tok * DM + head * 256);
        float r1[16], r2[16];
#pragma unroll
        for (int j = 0; j < 16; ++j) { r1[j] = -INFINITY; r2[j] = -INFINITY; }
#define RT_INS(R, W, IDX) { const float lo_ = __uint_as_float(((W) << 16) | (unsigned)(IDX)), hi_ = __uint_as_float(((W) & 0xffff0000u) | (unsigned)((IDX) + 1)); INS16(R, lo_) INS16(R, hi_) }
        for (int i8 = 0; i8 < 2; ++i8) {
            u32x4 a[8];
#pragma unroll
            for (int q = 0; q < 8; ++q) a[q] = sp[8 * i8 + q];
#pragma unroll
            for (int q = 0; q < 8; ++q) { const int b8 = 8 * (8 * i8 + q); RT_INS(r1, a[q].x, b8) RT_INS(r1, a[q].y, b8 + 2) RT_INS(r1, a[q].z, b8 + 4) RT_INS(r1, a[q].w, b8 + 6) }
        }
        for (int i8 = 0; i8 < 2; ++i8) {
            u32x4 a[8];
#pragma unroll
            for (int q = 0; q < 8; ++q) a[q] = sp[16 + 8 * i8 + q];
#pragma unroll
            for (int q = 0; q < 8; ++q) { const int b8 = 8 * (8 * i8 + q); RT_INS(r2, a[q].x, b8) RT_INS(r2, a[q].y, b8 + 2) RT_INS(r2, a[q].z, b8 + 4) RT_INS(r2, a[q].w, b8 + 6) }
        }
#undef RT_INS
        unsigned* sidx = (unsigned*)lds;
#pragma unroll
        for (int d = 0; d < 4; ++d) {
            sidx[d * 512 + threadIdx.x] = (__float_as_uint(r1[4 * d]) & 127u) | ((__float_as_uint(r1[4 * d + 1]) & 127u) << 8) | ((__float_as_uint(r1[4 * d + 2]) & 127u) << 16) | ((__float_as_uint(r1[4 * d + 3]) & 127u) << 24);
            sidx[(4 + d) * 512 + threadIdx.x] = (__float_as_uint(r2[4 * d]) & 127u) | ((__float_as_uint(r2[4 * d + 1]) & 127u) << 8) | ((__float_as_uint(r2[4 * d + 2]) & 127u) << 16) | ((__float_as_uint(r2[4 * d + 3]) & 127u) << 24);
        }
        float bk[16];
#pragma unroll
        for (int j = 0; j < 16; ++j) bk[j] = -INFINITY;
#pragma unroll
        for (int a = 0; a < 16; ++a)
#pragma unroll
            for (int b = 0; b < 16; ++b)
                if ((a + 1) * (b + 1) <= 16) {
                    const float ksum = __uint_as_float(__float_as_uint(r1[a]) & 0xffffff80u) + __uint_as_float(__float_as_uint(r2[b]) & 0xffffff80u);
                    const float key = __uint_as_float((__float_as_uint(ksum) & 0xffffff00u) | (unsigned)(a * 16 + b));
                    INS16(bk, key)
                }
        int bpay[16];
#pragma unroll
        for (int j = 0; j < 16; ++j) {
            const unsigned pos = __float_as_uint(bk[j]) & 255u, pa = pos >> 4, pb = pos & 15u;
            const unsigned i1 = (sidx[(pa >> 2) * 512 + threadIdx.x] >> (8 * (pa & 3))) & 127u, i2 = (sidx[(4 + (pb >> 2)) * 512 + threadIdx.x] >> (8 * (pb & 3))) & 127u;
            bpay[j] = (int)((i1 << 7) | i2);
        }
        float ex[16], ssum = 0.f;
#pragma unroll
        for (int j = 0; j < 16; ++j) { ex[j] = __expf(bk[j] - bk[0]); ssum += ex[j]; }
        const float inv = 1.0f / ssum;
        int* ed = sel_eid + tok * 128 + head * 16; float* gd = sel_gate + tok * 128 + head * 16;
#pragma unroll
        for (int j4 = 0; j4 < 4; ++j4) {
            *(int4*)(ed + 4 * j4) = make_int4(bpay[4 * j4], bpay[4 * j4 + 1], bpay[4 * j4 + 2], bpay[4 * j4 + 3]);
            *(float4*)(gd + 4 * j4) = make_float4(ex[4 * j4] * inv, ex[4 * j4 + 1] * inv, ex[4 * j4 + 2] * inv, ex[4 * j4 + 3] * inv);
        }
    }
}

template <int CTRL> DI float dpp_f(float x) { return __int_as_float(__builtin_amdgcn_update_dpp(0, __float_as_int(x), CTRL, 0xf, 0xf, false)); }
DI float sum8(float x) { x += dpp_f<0xB1>(x); x += dpp_f<0x4E>(x); x += dpp_f<0x141>(x); return x; }
#define FP4PAIR(wd, b) __builtin_amdgcn_cvt_scalef32_pk_f32_fp4((wd), 1.0f, (b))
DI void peerA_step(u32x4 (&cur)[16], u32x4 (&nxt)[16], const u32x4 (&hcur)[4], u32x4 (&hnxt)[4], int (&eidN)[16], const unsigned char* Ubase, unsigned loff,
                   const bf16_t* hn_ptr, const int* epnn, float* pp, bool do_store, int g, int j) {
#pragma unroll
    for (int i = 0; i < 16; ++i) nxt[i] = *(const u32x4*)(Ubase + (((unsigned)eidN[i] << 7) + loff));
#pragma unroll
    for (int k = 0; k < 4; ++k) hnxt[k] = (*(const u32x4*)(hn_ptr + 8 * k));
#pragma unroll
    for (int i = 0; i < 16; ++i) eidN[i] = (*(epnn + 8 * i));
    unsigned hw[16];
#pragma unroll
    for (int k = 0; k < 4; ++k) { hw[4 * k] = hcur[k].x; hw[4 * k + 1] = hcur[k].y; hw[4 * k + 2] = hcur[k].z; hw[4 * k + 3] = hcur[k].w; }
#pragma unroll
    for (int q = 0; q < 16; ++q) asm volatile("" : "+v"(hw[q]));
    float part[16];
#pragma unroll
    for (int i = 0; i < 16; ++i) {
        float a = 0.f;
#pragma unroll
        for (int k = 0; k < 4; ++k) {
            a = __builtin_amdgcn_fdot2_f32_bf16(__builtin_amdgcn_cvt_scalef32_pk_bf16_fp4(cur[i][k], 1.0f, 0), __builtin_bit_cast(bf16x2_t, hw[4 * k + 0]), a, false);
            a = __builtin_amdgcn_fdot2_f32_bf16(__builtin_amdgcn_cvt_scalef32_pk_bf16_fp4(cur[i][k], 1.0f, 1), __builtin_bit_cast(bf16x2_t, hw[4 * k + 1]), a, false);
            a = __builtin_amdgcn_fdot2_f32_bf16(__builtin_amdgcn_cvt_scalef32_pk_bf16_fp4(cur[i][k], 1.0f, 2), __builtin_bit_cast(bf16x2_t, hw[4 * k + 2]), a, false);
            a = __builtin_amdgcn_fdot2_f32_bf16(__builtin_amdgcn_cvt_scalef32_pk_bf16_fp4(cur[i][k], 1.0f, 3), __builtin_bit_cast(bf16x2_t, hw[4 * k + 3]), a, false);
        }
        part[i] = a;
    }
    const bool b0 = (j & 1) != 0, b1 = (j & 2) != 0, b2 = (j & 4) != 0;
    float r8[8], r4[4], r2[2];
#pragma unroll
    for (int k = 0; k < 8; ++k) { const float keep = b0 ? part[8 + k] : part[k], send = b0 ? part[k] : part[8 + k]; r8[k] = keep + dpp_f<0xB1>(send); }
#pragma unroll
    for (int k = 0; k < 4; ++k) { const float keep = b1 ? r8[4 + k] : r8[k], send = b1 ? r8[k] : r8[4 + k]; r4[k] = keep + dpp_f<0x4E>(send); }
#pragma unroll
    for (int k = 0; k < 2; ++k) { const float keep = b2 ? r4[2 + k] : r4[k], send = b2 ? r4[k] : r4[2 + k]; r2[k] = keep + dpp_f<0x1B>(dpp_f<0x141>(send)); }
    const int i0 = (b0 ? 8 : 0) + (b1 ? 4 : 0) + (b2 ? 2 : 0);
    if (do_store) { __builtin_nontemporal_store(r2[0], pp + 8 * i0 + g); __builtin_nontemporal_store(r2[1], pp + 8 * i0 + 8 + g); }
}
DI void peerA_phase(const bf16_t* __restrict__ H, const unsigned char* __restrict__ U4, const int* __restrict__ sel_eid, float* __restrict__ P, int bid, int nb) {
    const int lane = threadIdx.x & 63, w = threadIdx.x >> 6, g = lane >> 3, j = lane & 7;
    const int s = bid & 7, nxb = nb >> 3;
    if ((bid >> 3) >= nxb) return;
    const int widx = (bid >> 3) * 8 + w, nw = nxb * 8;
    const int ntok = (TOK - widx + nw - 1) / nw;
    const size_t coff = (size_t)(256 * s + 32 * j); const unsigned char* Ubase = U4 + (size_t)s * (16384 * 128); const unsigned loff = 16u * j;
    int eidN[16]; u32x4 uvA[16], uvB[16]; u32x4 hA[4], hB[4];
    {   const int t0 = widx, t1 = ntok > 1 ? widx + nw : widx;
        const int* ep = sel_eid + (size_t)t0 * 128 + g;
#pragma unroll
        for (int i = 0; i < 16; ++i) eidN[i] = (*(ep + 8 * i));
#pragma unroll
        for (int k = 0; k < 4; ++k) hA[k] = (*(const u32x4*)(H + (size_t)t0 * DM + coff + 8 * k));
#pragma unroll
        for (int i = 0; i < 16; ++i) uvA[i] = *(const u32x4*)(Ubase + (((unsigned)eidN[i] << 7) + loff));
        ep = sel_eid + (size_t)t1 * 128 + g;
#pragma unroll
        for (int i = 0; i < 16; ++i) eidN[i] = (*(ep + 8 * i));
    }
#define TOKC(x) (widx + ((x) < ntok ? (x) : ntok - 1) * nw)
    for (int it = 0; it < ntok; it += 2) {
        {   const int t = TOKC(it), tn = TOKC(it + 1), tnn = TOKC(it + 2);
            peerA_step(uvA, uvB, hA, hB, eidN, Ubase, loff, H + (size_t)tn * DM + coff, sel_eid + (size_t)tnn * 128 + g, P + ((size_t)t * 8 + s) * 128, true, g, j); }
        {   const int t = TOKC(it + 1), tn = TOKC(it + 2), tnn = TOKC(it + 3);
            peerA_step(uvB, uvA, hB, hA, eidN, Ubase, loff, H + (size_t)tn * DM + coff, sel_eid + (size_t)tnn * 128 + g, P + ((size_t)t * 8 + s) * 128, it + 1 < ntok, g, j); }
    }
}
DI void peerC_phase(const float* __restrict__ P, const int* __restrict__ sel_eid, const float* __restrict__ sel_gate, const float* __restrict__ Us, const float* __restrict__ Vs, float* __restrict__ C, int bid, int nb) {
    const int lane = threadIdx.x & 63, w = threadIdx.x >> 6;
    for (int t = bid * 8 + w; t < TOK; t += nb * 8) {
        const float* pp = P + (size_t)t * 1024;
        float d0 = 0.f, d1 = 0.f;
#pragma unroll
        for (int s = 0; s < 8; ++s) { d0 += pp[s * 128 + lane]; d1 += pp[s * 128 + 64 + lane]; }
        const int e0 = sel_eid[(size_t)t * 128 + lane], e1 = sel_eid[(size_t)t * 128 + 64 + lane];
        C[(size_t)t * 128 + lane] = sel_gate[(size_t)t * 128 + lane] * Vs[e0] * gelu_f(d0 * Us[e0]);
        C[(size_t)t * 128 + 64 + lane] = sel_gate[(size_t)t * 128 + 64 + lane] * Vs[e1] * gelu_f(d1 * Us[e1]);
    }
}
DI void peerB_step(u32x4 (&cur)[16], u32x4 (&nxt)[16], const float (&cfcur)[16], float (&cfnxt)[16], int (&eidN)[16], const unsigned char* Vbase, unsigned loff,
                   const float* cpn, const int* epnn, bf16_t* op, bool do_store, bool b3) {
#pragma unroll
    for (int i = 0; i < 16; ++i) nxt[i] = *(const u32x4*)(Vbase + (((unsigned)eidN[i] << 7) + loff));
#pragma unroll
    for (int i = 0; i < 16; ++i) { eidN[i] = (*(epnn + 8 * i)); cfnxt[i] = (*(cpn + 8 * i)); }
    f32x2_t o[16];
#pragma unroll
    for (int k = 0; k < 16; ++k) o[k] = (f32x2_t){0.f, 0.f};
#pragma unroll
    for (int i = 0; i < 16; ++i) {
        const f32x2_t c2 = {cfcur[i], cfcur[i]};
#pragma unroll
        for (int k = 0; k < 4; ++k) {
            o[4 * k + 0] = FP4PAIR(cur[i][k], 0) * c2 + o[4 * k + 0]; o[4 * k + 1] = FP4PAIR(cur[i][k], 1) * c2 + o[4 * k + 1];
            o[4 * k + 2] = FP4PAIR(cur[i][k], 2) * c2 + o[4 * k + 2]; o[4 * k + 3] = FP4PAIR(cur[i][k], 3) * c2 + o[4 * k + 3];
        }
    }
    f32x2_t q8[8];
#pragma unroll
    for (int k = 0; k < 8; ++k) {
        const u32x2 sx = __builtin_amdgcn_permlane32_swap(__float_as_uint(o[k].x), __float_as_uint(o[8 + k].x), false, false);
        const u32x2 sy = __builtin_amdgcn_permlane32_swap(__float_as_uint(o[k].y), __float_as_uint(o[8 + k].y), false, false);
        q8[k] = (f32x2_t){__uint_as_float(sx.x) + __uint_as_float(sx.y), __uint_as_float(sy.x) + __uint_as_float(sy.y)};
    }
    f32x2_t q4[4];
#pragma unroll
    for (int k = 0; k < 4; ++k) {
        const u32x2 sx = __builtin_amdgcn_permlane16_swap(__float_as_uint(q8[k].x), __float_as_uint(q8[4 + k].x), false, false);
        const u32x2 sy = __builtin_amdgcn_permlane16_swap(__float_as_uint(q8[k].y), __float_as_uint(q8[4 + k].y), false, false);
        q4[k] = (f32x2_t){__uint_as_float(sx.x) + __uint_as_float(sx.y), __uint_as_float(sy.x) + __uint_as_float(sy.y)};
    }
    f32x4 fin;
#pragma unroll
    for (int k = 0; k < 2; ++k) {
        const f32x2_t keep = b3 ? q4[2 + k] : q4[k], send = b3 ? q4[k] : q4[2 + k];
        fin[2 * k] = keep.x + dpp_f<0x128>(send.x); fin[2 * k + 1] = keep.y + dpp_f<0x128>(send.y);
    }
    if (do_store) { u32x2 fo; fo.x = pk2(fin[0], fin[1]); fo.y = pk2(fin[2], fin[3]); __builtin_nontemporal_store(fo, (u32x2*)op); }
}
DI void peerB_phase(const unsigned char* __restrict__ V4, const int* __restrict__ sel_eid, const float* __restrict__ C, float* __restrict__ outpre, int bid, int nb) {
    const int lane = threadIdx.x & 63, w = threadIdx.x >> 6, g = lane >> 3, j = lane & 7;
    const int s = bid & 7, nxb = nb >> 3;
    if ((bid >> 3) >= nxb) return;
    const int widx = (bid >> 3) * 8 + w, nw = nxb * 8;
    const int ntok = (TOK - widx + nw - 1) / nw;
    const bool b5 = (lane & 32) != 0, b4 = (lane & 16) != 0, b3 = (lane & 8) != 0;
    const int qidx = (b5 ? 4 : 0) + (b4 ? 2 : 0) + (b3 ? 1 : 0);
    const size_t coff = (size_t)(256 * s + 32 * j) + 4 * qidx; const unsigned char* Vbase = V4 + (size_t)s * (16384 * 128); const unsigned loff = 16u * j;
    int eidN[16]; float cfA[16], cfB[16]; u32x4 vvA[16], vvB[16];
    {   const int t0 = widx, t1 = ntok > 1 ? widx + nw : widx;
        const int* ep = sel_eid + (size_t)t0 * 128 + g; const float* cp = C + (size_t)t0 * 128 + g;
#pragma unroll
        for (int i = 0; i < 16; ++i) { eidN[i] = (*(ep + 8 * i)); cfA[i] = (*(cp + 8 * i)); }
#pragma unroll
        for (int i = 0; i < 16; ++i) vvA[i] = *(const u32x4*)(Vbase + (((unsigned)eidN[i] << 7) + loff));
        ep = sel_eid + (size_t)t1 * 128 + g;
#pragma unroll
        for (int i = 0; i < 16; ++i) eidN[i] = (*(ep + 8 * i));
    }
    for (int it = 0; it < ntok; it += 2) {
        {   const int t = TOKC(it), tn = TOKC(it + 1), tnn = TOKC(it + 2);
            peerB_step(vvA, vvB, cfA, cfB, eidN, Vbase, loff, C + (size_t)tn * 128 + g, sel_eid + (size_t)tnn * 128 + g, (bf16_t*)(outpre + (size_t)t * DM) + coff, true, b3); }
        {   const int t = TOKC(it + 1), tn = TOKC(it + 2), tnn = TOKC(it + 3);
            peerB_step(vvB, vvA, cfB, cfA, eidN, Vbase, loff, C + (size_t)tn * 128 + g, sel_eid + (size_t)tnn * 128 + g, (bf16_t*)(outpre + (size_t)t * DM) + coff, it + 1 < ntok, b3); }
    }
#undef TOKC
}
DI void ln2_phase(const bf16_t* __restrict__ H, float* io, const float* __restrict__ g, const float* __restrict__ b, int bid, int nb) {
    const int lane = threadIdx.x & 63, w = threadIdx.x >> 6;
    for (int t = bid * 8 + w; t < TOK; t += nb * 8) {
        float v[32]; float s = 0.f;
#pragma unroll
        for (int i = 0; i < 4; ++i) {
            const int c0 = (lane + 64 * i) * 8;
            const u32x4 hv = *(const u32x4*)(H + (size_t)t * DM + c0);
            const u32x4 ov = *(const u32x4*)((const bf16_t*)(io + (size_t)t * DM) + c0);
            const f32x4 a = {bf_lo(ov.x), bf_hi(ov.x), bf_lo(ov.y), bf_hi(ov.y)}, c = {bf_lo(ov.z), bf_hi(ov.z), bf_lo(ov.w), bf_hi(ov.w)};
            v[8 * i + 0] = a[0] + ALPHA * bf_lo(hv[0]); v[8 * i + 1] = a[1] + ALPHA * bf_hi(hv[0]); v[8 * i + 2] = a[2] + ALPHA * bf_lo(hv[1]); v[8 * i + 3] = a[3] + ALPHA * bf_hi(hv[1]);
            v[8 * i + 4] = c[0] + ALPHA * bf_lo(hv[2]); v[8 * i + 5] = c[1] + ALPHA * bf_hi(hv[2]); v[8 * i + 6] = c[2] + ALPHA * bf_lo(hv[3]); v[8 * i + 7] = c[3] + ALPHA * bf_hi(hv[3]);
#pragma unroll
            for (int k = 0; k < 8; ++k) s += v[8 * i + k];
        }
        s = wave_sum(s); const float mu = s * (1.0f / 2048.0f); float q = 0.f;
#pragma unroll
        for (int k = 0; k < 32; ++k) { const float d = v[k] - mu; q += d * d; }
        q = wave_sum(q); const float rstd = rsqrtf(q * (1.0f / 2048.0f) + 1e-5f);
#pragma unroll
        for (int i = 0; i < 4; ++i) {
            const int c0 = (lane + 64 * i) * 8;
            const f32x4 ga = *(const f32x4*)(g + c0), gb = *(const f32x4*)(g + c0 + 4), ba = *(const f32x4*)(b + c0), bb = *(const f32x4*)(b + c0 + 4);
            f32x4 y0, y1;
#pragma unroll
            for (int k = 0; k < 4; ++k) { y0[k] = (v[8 * i + k] - mu) * rstd * ga[k] + ba[k]; y1[k] = (v[8 * i + 4 + k] - mu) * rstd * gb[k] + bb[k]; }
            *(f32x4*)(io + (size_t)t * DM + c0) = y0; *(f32x4*)(io + (size_t)t * DM + c0 + 4) = y1;
        }
    }
}

#define XB_TMO      128
#define XB_XCNT(j)  (256  + 64 * (j))
#define XB_XSUB(j)  (1280 + 64 * (j))
#define XB_XGEN(j)  (2304 + 64 * (j))
#define XB_TOP      3328
#define XB_TOPGEN   3392
#define XCD_BAR_WORDS 3456
#define XB_SPIN_CAP (1u << 18)
#define LAS __attribute__((address_space(3)))

__device__ __forceinline__ unsigned xb_ld(unsigned* p)              { return __hip_atomic_load(p, __ATOMIC_RELAXED, __HIP_MEMORY_SCOPE_AGENT); }
__device__ __forceinline__ unsigned xb_add(unsigned* p, unsigned v) { return __hip_atomic_fetch_add(p, v, __ATOMIC_RELAXED, __HIP_MEMORY_SCOPE_AGENT); }
__device__ __forceinline__ unsigned xb_xcc_id() { return (unsigned)__builtin_amdgcn_s_getreg((3 << 11) | 20) & 0xFu; }
#define XB_SPIN(cond, bar) do { unsigned _sp = 0; while (cond) { __builtin_amdgcn_s_sleep(1); \
    if ((++_sp & 255u) == 0u) { if (xb_ld(&(bar)[XB_TMO])) break; if (_sp > XB_SPIN_CAP) { atomicAdd(&(bar)[XB_TMO], 1u); break; } } } } while (0)

struct XcdBarrier {
    unsigned* bar; unsigned x;
    volatile LAS unsigned* st;
};

__device__ __forceinline__ XcdBarrier xcd_barrier_post(unsigned* bar, volatile LAS unsigned* st) {
    XcdBarrier b; b.bar = bar; b.x = xb_xcc_id(); b.st = st;
    if (threadIdx.x == 0) (void)xb_add(&bar[XB_XCNT(b.x)], 1u);
    return b;
}
__device__ __forceinline__ void xcd_barrier_complete(unsigned* bar, unsigned x, unsigned& nloc, unsigned& nx) {
    const unsigned G = gridDim.x * gridDim.y * gridDim.z;
    unsigned sum, cnt, mine, sp = 0u;
    for (;;) {
        sum = 0u; cnt = 0u; mine = 0u;
#pragma unroll
        for (unsigned j = 0; j < 16; ++j) { const unsigned c = xb_ld(&bar[XB_XCNT(j)]); sum += c; cnt += (c > 0u) ? 1u : 0u; mine = (j == x) ? c : mine; }
        if (sum == G) break;
        __builtin_amdgcn_s_sleep(1);
        if ((++sp & 255u) == 0u) { if (xb_ld(&bar[XB_TMO])) break; if (sp > XB_SPIN_CAP) { atomicAdd(&bar[XB_TMO], 1u); break; } }
    }
    nloc = mine > 0u ? mine : 1u; nx = cnt > 0u ? cnt : 1u;
}

__device__ __forceinline__ void xcd_barrier(const XcdBarrier& b) {
    asm volatile("s_waitcnt vmcnt(0)" ::: "memory");
    __syncthreads();
    if (threadIdx.x == 0) {
        unsigned* bar = b.bar;
        __builtin_amdgcn_s_waitcnt(0);
        unsigned nloc = b.st[0], nx = b.st[1];
        if (nloc == 0u) { xcd_barrier_complete(bar, b.x, nloc, nx); b.st[0] = nloc; b.st[1] = nx; }
        const unsigned old = xb_add(&bar[XB_XSUB(b.x)], 1u);
        const unsigned gen = old / nloc;
        if (old + 1u == (gen + 1u) * nloc) {
            __builtin_amdgcn_fence(__ATOMIC_RELEASE, "agent");
            asm volatile("s_waitcnt vmcnt(0)" ::: "memory");
            const unsigned og = xb_add(&bar[XB_TOP], 1u);
            const unsigned tg = og / nx;
            if (og + 1u == (tg + 1u) * nx) xb_add(&bar[XB_TOPGEN], 1u);
            else XB_SPIN(xb_ld(&bar[XB_TOPGEN]) == tg, bar);
            __builtin_amdgcn_fence(__ATOMIC_ACQUIRE, "agent");
            xb_add(&bar[XB_XGEN(b.x)], 1u);
            asm volatile("s_waitcnt vmcnt(0)" ::: "memory");
        } else {
            XB_SPIN(xb_ld(&bar[XB_XGEN(b.x)]) == gen, bar);
            __builtin_amdgcn_fence(__ATOMIC_ACQUIRE, "agent");
            asm volatile("s_waitcnt vmcnt(0)" ::: "memory");
        }
    }
    __syncthreads();
}

__global__ void __launch_bounds__(512) hymba_fwd(Params p) {
    extern __shared__ __attribute__((aligned(16))) unsigned char lds[];
    cg::grid_group grid = cg::this_grid();
    volatile LAS unsigned* bst = (volatile LAS unsigned*)(lds + 131072);
    if (threadIdx.x < 2) bst[threadIdx.x] = 0u;
    __syncthreads();
    const XcdBarrier xbar = xcd_barrier_post((unsigned*)(p.ws + WS_END + 131072), bst);
    const int bid = blockIdx.x, nb = gridDim.x;
    unsigned char* ws = p.ws;
    bf16_t* xb = (bf16_t*)(ws + WS_R0); bf16_t* mix = (bf16_t*)(ws + WS_R2);
    unsigned char* U8 = ws + WS_R0 + 96 * MiB; unsigned char* V8 = ws + WS_R0 + 112 * MiB; float* Us = (float*)(ws + WS_END); float* Vs = Us + 16384;
    bf16_t* Uc = (bf16_t*)(ws + WS_R1); bf16_t* BG = (bf16_t*)(ws + WS_R1 + 48 * MiB); bf16_t* Z = (bf16_t*)(ws + WS_R1);
    bf16_t* KVf = (bf16_t*)(ws + WS_R2); bf16_t* KVb = (bf16_t*)(ws + WS_R2 + 48 * MiB); bf16_t* H = (bf16_t*)(ws + WS_R2);
    bf16_t* Sf = (bf16_t*)(ws + WS_R3); bf16_t* Sb = (bf16_t*)(ws + WS_R3 + 48 * MiB);
    bf16_t* WinT = (bf16_t*)(ws + WS_W); bf16_t* WoutT = (bf16_t*)(ws + WS_W + 28 * MiB); bf16_t* WqkT = (bf16_t*)(ws + WS_W + 36 * MiB);
    bf16_t* Q = (bf16_t*)p.out; bf16_t* K = Q + (size_t)TOK * RW; bf16_t* V = K + (size_t)TOK * RW; bf16_t* G = V + (size_t)TOK * RW;

#ifndef PH_MASK
#define PH_MASK 0xFFFF
#endif
    if (PH_MASK & 1) {
    convert_flat(p.x_prompt, xb, (size_t)8192 * DM / 8, bid, nb);
    convert_flat(p.x_sample, xb + (size_t)8192 * DM, (size_t)16384 * DM / 8, bid, nb);
    transpose_convert<true>(p.w_in, NPROJ, WinT, NPROJ, bid, nb);
    transpose_convert<false>(p.w_out, DM, WoutT, DM, bid, nb);
    fold_phase(p.w_query, p.keys1, p.keys2, WqkT, lds, bid, nb);
    }
    if (p.ws == nullptr) grid.sync();
    xcd_barrier(xbar);
    if (PH_MASK & 2) {
        pg8::Gemm g{xb, WinT, TOK, NPROJ, DM}; pg8::StaticOrder S; S.init(TOK, NPROJ, nb, bid);
        EpiInProj E{Q, Uc, BG};
        pg8::gemm_phase<EpiInProj, pg8::StaticOrder, false>((PG8_LAS unsigned char*)lds, g, S, E, nullptr);
        const int rem = ((TOK / 256) * (NPROJ / 256)) % nb;
        if (rem) { if (bid >= rem) table_fp4_phase(p.peer_u, U8, Us, bid - rem, nb - rem); } else table_fp4_phase(p.peer_u, U8, Us, bid, nb);
    }
    xcd_barrier(xbar);
    if (PH_MASK & 4) r1_phase(K, V, KVf, KVb, p.rate_f, p.rate_b, lds, bid, nb);
    xcd_barrier(xbar);
    if (PH_MASK & 8) r2_phase(KVf, KVb, Sf, Sb, p.rate_f, p.rate_b, bid, nb);
    const int scan_wgs = (98304 + 511) / 512, vsplit = nb > scan_wgs ? 4096 : 0;
    if (vsplit && bid >= scan_wgs) table_fp4_phase(p.peer_v, V8, Vs, bid - scan_wgs, nb - scan_wgs, 0, vsplit);
    xcd_barrier(xbar);
    if (PH_MASK & 16) r3_phase(Q, K, V, G, Sf, Sb, p.rate_f, p.rate_b, p.gn_g, mix, lds, bid, nb);
    if (PH_MASK & 32) conv_phase(Uc, BG, p.conv_w, mix, bid, nb);
    xcd_barrier(xbar);
    if (PH_MASK & 64) {
        pg8::Gemm g{mix, WoutT, TOK, DM, DM}; pg8::StaticOrder S; S.init(TOK, DM, nb, bid);
        EpiOutProj E{Z};
        pg8::gemm_phase<EpiOutProj, pg8::StaticOrder, false>((PG8_LAS unsigned char*)lds, g, S, E, nullptr);
    }
    xcd_barrier(xbar);
    if (PH_MASK & 128) ln1_phase(Z, xb, p.ln1_g, p.ln1_b, H, bid, nb);
    table_fp4_phase(p.peer_v, V8, Vs, bid, nb, vsplit, 16384);
    xcd_barrier(xbar);
    if (PH_MASK & 256) {
        pg8::Gemm g{H, WqkT, TOK, DM, DM}; pg8::StaticOrder S; S.init(TOK, DM, nb, bid);
        EpiScore E{(bf16_t*)p.out};
        pg8::gemm_phase<EpiScore, pg8::StaticOrder, false>((PG8_LAS unsigned char*)lds, g, S, E, nullptr);
    }
    xcd_barrier(xbar);
    {
        int* sel_eid = (int*)(ws + WS_R1); float* sel_gate = (float*)(ws + WS_R1 + 16 * MiB); float* Cf = (float*)(ws + WS_R1 + 32 * MiB);
        route_phase(p.out, sel_eid, sel_gate, lds, bid, nb);
        xcd_barrier(xbar);
        peerA_phase(H, U8, sel_eid, p.out, bid, nb);
        xcd_barrier(xbar);
        peerC_phase(p.out, sel_eid, sel_gate, Us, Vs, Cf, bid, nb);
        xcd_barrier(xbar);
        peerB_phase(V8, sel_eid, Cf, p.out, bid, nb);
        xcd_barrier(xbar);
        ln2_phase(H, p.out, p.ln2_g, p.ln2_b, bid, nb);
    }
}

extern "C" void kernel_launch(void* const* d_in, const int* in_sizes, int n_in, void* d_out, int out_size, void* d_ws, size_t ws_size, hipStream_t stream) {
    constexpr int LDS_BYTES = 131072 + 16;
    static int grid_blocks = 0;
    if (!grid_blocks) {
        int dev = 0, cus = 0, per_cu = 0;
        hipGetDevice(&dev);
        hipDeviceGetAttribute(&cus, hipDeviceAttributeMultiprocessorCount, dev);
        hipFuncSetAttribute((const void*)hymba_fwd, hipFuncAttributeMaxDynamicSharedMemorySize, LDS_BYTES);
        hipOccupancyMaxActiveBlocksPerMultiprocessor(&per_cu, (const void*)hymba_fwd, 512, LDS_BYTES);
        if (per_cu < 1) per_cu = 1;
        grid_blocks = cus * per_cu;
        if (ws_size < WS_END + 131072 + XCD_BAR_WORDS * 4) fprintf(stderr, "kernel_launch: workspace too small: %zu < %zu\n", ws_size, (size_t)WS_END);
    }
    (void)hipMemsetAsync((unsigned char*)d_ws + WS_END + 131072, 0, XCD_BAR_WORDS * 4, stream);
    Params p{};
    const float** pp = (const float**)&p;
    for (int i = 0; i < 17; ++i) pp[i] = (const float*)d_in[i];
    p.out = (float*)d_out; p.ws = (unsigned char*)d_ws;
    void* args[] = {&p};
    hipError_t e = hipLaunchCooperativeKernel((const void*)hymba_fwd, dim3(grid_blocks), dim3(512), args, LDS_BYTES, stream);
    if (e != hipSuccess) fprintf(stderr, "cooperative launch failed: %s (grid %d)\n", hipGetErrorString(e), grid_blocks);
}
```

```cpp
#include <hip/hip_runtime.h>
#include <hip/hip_cooperative_groups.h>
#include <cstdio>
namespace cg = cooperative_groups;
namespace pg8 {
#define PG8_LAS __attribute__((address_space(3)))
typedef unsigned short bf16_t;
typedef short bf16x8 __attribute__((ext_vector_type(8)));
typedef float f32x4 __attribute__((ext_vector_type(4)));
typedef unsigned u32x4 __attribute__((ext_vector_type(4)));
constexpr int BM = 256, BK = 64, HALF = 128, HTB = HALF * BK * 2  , STAGE_BYTES = 8 * HTB, NXCD = 8, WGM = 8;

__host__ __device__ __forceinline__ int lds_byte(int r, int c) { const int st = (r >> 4) * 2 + (c >> 5), rr = r & 15, cc = c & 31, ob = rr * 64 + cc * 2; return st * 1024 + (ob ^ (((ob >> 9) & 1) << 5)); }
__host__ __device__ __forceinline__ void stage_rc(int b, int& R, int& C) { const int st = b / 1024, sb = b % 1024, swz = sb ^ (((sb >> 9) & 1) << 5); R = (st >> 1) * 16 + swz / 64; C = (st & 1) * 32 + (swz % 64) / 2; }
__host__ __device__ __forceinline__ int perm32(int rho) { const int n = rho >> 4, i = rho & 15; return 8 * (i >> 2) + 4 * n + (i & 3); }

struct Unit { int pm, pn; };
struct Gemm { const bf16_t* A; const bf16_t* Bt; int M, N, K; };

struct StaticOrder {
    int nM, nN, nwg, G, c;
    __host__ __device__ void init(int M, int N, int G_, int c_) { nM = M / BM; nN = N / BM; nwg = nM * nN; G = G_; c = c_; }
    __host__ __device__ bool next(int i, Unit& u) const {
        const long L = (long)i * G + c; if (L >= nwg) return false;
        int wgid = (int)L; { const int q = nwg / NXCD, r = nwg % NXCD, xcd = wgid % NXCD, off = wgid / NXCD; wgid = (xcd < r ? xcd * (q + 1) : r * (q + 1) + (xcd - r) * q) + off; }
        const int nig = WGM * nN, gid = wgid / nig, fm = gid * WGM, gsz = (nM - fm) < WGM ? (nM - fm) : WGM;
        u.pm = fm + ((wgid % nig) % gsz); u.pn = (wgid % nig) / gsz; return true;
    }
    __device__ __forceinline__ void a_ready(const Unit&) const {}
    __device__ __forceinline__ void done(const Unit&) const {}
};
template <class Epi, class Sched, bool STAMP = false>
__device__ __forceinline__ void gemm_phase(PG8_LAS unsigned char* lds, const Gemm g, const Sched& S, const Epi& E, unsigned long long* stamps) {
    const int tid = threadIdx.x, wid = __builtin_amdgcn_readfirstlane(tid >> 6), lane = tid & 63, wr = wid >> 2, wc = wid & 3, fr = lane & 15, fq = lane >> 4;
    const int K = g.K, nt = K / BK;
    int ts_lo = 0, ts_hi = 0, nts = 0; const unsigned long long rt_entry = STAMP ? (unsigned long long)wall_clock64() : 0ull;
#define PG8_STAMP() do { if (STAMP && wid == 0 && nts < 64) { const unsigned long long _c = (unsigned long long)clock64(); \
        ts_lo = (lane == nts) ? (int)(unsigned)_c : ts_lo; ts_hi = (lane == nts) ? (int)(unsigned)(_c >> 32) : ts_hi; ++nts; } } while (0)
    PG8_STAMP();
    unsigned voffA[2], voffB[2];
#pragma unroll
    for (int i = 0; i < 2; ++i) { int R, C; stage_rc(tid * 16 + i * 8192, R, C); const int Rb = Epi::PERM ? ((R & ~31) + perm32(R & 31)) : R;
        voffA[i] = (unsigned)(R * K + C) * 2u; voffB[i] = (unsigned)(Rb * K + C) * 2u; }
    const size_t kstep = (size_t)(BK * 2);
    const size_t hstep = (size_t)HALF * K * 2;
    const size_t tstep = 2 * hstep;
    const unsigned ldsw = (unsigned)wid * 1024u;
    const int aoff = lds_byte(wr * 64 + fr, fq * 8), boff = lds_byte(wc * 32 + fr, fq * 8);
#define PG8_SA(b, h) (((b) * 2 + (h)) * HTB)
#define PG8_SB(b, h) ((4 + (b) * 2 + (h)) * HTB)
#define PG8_STAGE(bufoff, gbase, voff) do { _Pragma("unroll") for (int _i = 0; _i < 2; ++_i) \
        __builtin_amdgcn_global_load_lds((const unsigned*)((const char*)(gbase) + (voff)[_i]), (PG8_LAS unsigned*)(lds + (bufoff) + ldsw + _i * 8192), 16, 0, 0); } while (0)
#define PG8_LDA(dst, b, h) do { _Pragma("unroll") for (int m = 0; m < 4; ++m) _Pragma("unroll") for (int k = 0; k < 2; ++k) dst[m][k] = *(const PG8_LAS bf16x8*)(lds + PG8_SA(b, h) + aoff + m * 2048 + k * 1024); } while (0)
#define PG8_LDB(dst, b, h) do { _Pragma("unroll") for (int n = 0; n < 2; ++n) _Pragma("unroll") for (int k = 0; k < 2; ++k) dst[n][k] = *(const PG8_LAS bf16x8*)(lds + PG8_SB(b, h) + boff + n * 2048 + k * 1024); } while (0)
#define PG8_MMA(ai, bj, At, Bt) do { __builtin_amdgcn_s_setprio(1); _Pragma("unroll") for (int m = 0; m < 4; ++m) _Pragma("unroll") for (int n = 0; n < 2; ++n) _Pragma("unroll") for (int k = 0; k < 2; ++k) \
        acc[ai][bj][m][n] = __builtin_amdgcn_mfma_f32_16x16x32_bf16(Bt[n][k], At[m][k], acc[ai][bj][m][n], 0, 0, 0); __builtin_amdgcn_s_setprio(0); } while (0)
#define PG8_WAIT_V(n) asm volatile("s_waitcnt vmcnt(" #n ")" ::: "memory")
#define PG8_WAIT_L(n) asm volatile("s_waitcnt lgkmcnt(" #n ")" ::: "memory")
#define PG8_BAR __builtin_amdgcn_s_barrier()
#define PG8_SCHED __builtin_amdgcn_sched_barrier(0)
    Unit cur, nxt; int ui = 0;
    if (!S.next(0, cur)) return;
    f32x4 acc[2][2][4][2];
#pragma unroll
    for (int a = 0; a < 2; ++a)
#pragma unroll
        for (int b = 0; b < 2; ++b)
#pragma unroll
            for (int m = 0; m < 4; ++m)
#pragma unroll
                for (int n = 0; n < 2; ++n) acc[a][b][m][n] = (f32x4){0.f, 0.f, 0.f, 0.f};
    bf16x8 At[4][2], B0[2][2], B1[2][2];
    const char* cA = (const char*)g.A + (size_t)cur.pm * tstep; const char* cB = (const char*)g.Bt + (size_t)cur.pn * tstep;
    S.a_ready(cur);
    PG8_STAGE(PG8_SB(0, 0), cB, voffB); PG8_STAGE(PG8_SA(0, 0), cA, voffA); PG8_STAGE(PG8_SB(0, 1), cB + hstep, voffB); PG8_STAGE(PG8_SA(0, 1), cA + hstep, voffA);
    if (wr == 1) PG8_BAR;
    PG8_WAIT_V(4); PG8_BAR;
    PG8_STAGE(PG8_SB(1, 0), cB + kstep, voffB); PG8_STAGE(PG8_SA(1, 0), cA + kstep, voffA); PG8_STAGE(PG8_SB(1, 1), cB + hstep + kstep, voffB);
    PG8_WAIT_V(6); PG8_BAR;
    PG8_STAMP();
    for (;;) {
        const bool has_next = S.next(ui + 1, nxt);
        const char* nA = has_next ? (const char*)g.A + (size_t)nxt.pm * tstep : cA; const char* nB = has_next ? (const char*)g.Bt + (size_t)nxt.pn * tstep : cB;
        for (int t = 0; t < nt; t += 2) {
            const bool last = (t == nt - 2);
            const char* a1 = cA + (size_t)(t + 1) * kstep;
            const char* a2 = last ? nA : cA + (size_t)(t + 2) * kstep; const char* b2 = last ? nB : cB + (size_t)(t + 2) * kstep;
            const char* a3 = a2 + kstep; const char* b3 = b2 + kstep;
            if (last && has_next) S.a_ready(nxt);
            PG8_LDB(B0, 0, 0); PG8_SCHED; PG8_LDA(At, 0, 0); PG8_STAGE(PG8_SA(1, 1), a1 + hstep, voffA);
            PG8_WAIT_L(8); PG8_BAR; PG8_WAIT_L(0); PG8_MMA(0, 0, At, B0); PG8_BAR; PG8_SCHED;
            PG8_LDB(B1, 0, 1); PG8_STAGE(PG8_SB(0, 0), b2, voffB);
            PG8_BAR; PG8_WAIT_L(0); PG8_MMA(0, 1, At, B1); PG8_BAR;
            PG8_LDA(At, 0, 1); PG8_STAGE(PG8_SA(0, 0), a2, voffA);
            PG8_BAR; PG8_WAIT_L(0); PG8_MMA(1, 0, At, B0); PG8_BAR; PG8_SCHED;
            PG8_STAGE(PG8_SB(0, 1), b2 + hstep, voffB);
            PG8_WAIT_V(6); PG8_BAR; PG8_MMA(1, 1, At, B1); PG8_BAR;
            PG8_LDB(B0, 1, 0); PG8_SCHED; PG8_LDA(At, 1, 0); PG8_STAGE(PG8_SA(0, 1), a2 + hstep, voffA);
            PG8_WAIT_L(8); PG8_BAR; PG8_WAIT_L(0); PG8_MMA(0, 0, At, B0); PG8_BAR; PG8_SCHED;
            PG8_LDB(B1, 1, 1); PG8_STAGE(PG8_SB(1, 0), b3, voffB);
            PG8_BAR; PG8_WAIT_L(0); PG8_MMA(0, 1, At, B1); PG8_BAR;
            PG8_LDA(At, 1, 1); PG8_STAGE(PG8_SA(1, 0), a3, voffA);
            PG8_BAR; PG8_WAIT_L(0); PG8_MMA(1, 0, At, B0); PG8_BAR; PG8_SCHED;
            PG8_STAGE(PG8_SB(1, 1), b3 + hstep, voffB);
            PG8_WAIT_V(6); PG8_BAR; PG8_MMA(1, 1, At, B1); PG8_BAR;
        }
        PG8_STAMP();
        if constexpr (!Epi::AFTER_DRAIN) { E(acc, cur, wr, wc, fr, fq); S.done(cur); }
        PG8_STAMP();
        if (!has_next) break;
#pragma unroll
        for (int a = 0; a < 2; ++a)
#pragma unroll
            for (int b = 0; b < 2; ++b)
#pragma unroll
                for (int m = 0; m < 4; ++m)
#pragma unroll
                    for (int n = 0; n < 2; ++n) acc[a][b][m][n] = (f32x4){0.f, 0.f, 0.f, 0.f};
        cur = nxt; cA = nA; cB = nB; ++ui;
    }
    PG8_WAIT_V(0);
    if (wr == 0) PG8_BAR;
    PG8_BAR;
    if constexpr (Epi::AFTER_DRAIN) { E.fused(acc, cur, wr, wc, fr, fq, lds, wid, lane); S.done(cur); }
    PG8_STAMP();
    if (STAMP && wid == 0) { stamps[lane] = lane < nts ? (((unsigned long long)(unsigned)ts_hi << 32) | (unsigned)ts_lo) : 0ull;
        if (lane == 62) stamps[62] = rt_entry; if (lane == 63) stamps[63] = (unsigned long long)wall_clock64(); }
#undef PG8_STAMP
#undef PG8_SA
#undef PG8_SB
#undef PG8_STAGE
#undef PG8_LDA
#undef PG8_LDB
#undef PG8_MMA
#undef PG8_WAIT_V
#undef PG8_WAIT_L
#undef PG8_BAR
#undef PG8_SCHED
}
}

using pg8::bf16_t; using pg8::bf16x8; using pg8::f32x4; using pg8::u32x4;
typedef unsigned u32x2 __attribute__((ext_vector_type(2)));
typedef __bf16 bf16x2_t __attribute__((ext_vector_type(2)));
typedef float f32x2_t __attribute__((ext_vector_type(2)));
#define DI __device__ __forceinline__

constexpr int TOK = 24576, DM = 2048, NPROJ = 7168, RW = 1024;
constexpr float ALPHA = 1.189207115002721f;
constexpr float LOG2E = 1.4426950408889634f;
constexpr size_t MiB = 1048576;
constexpr size_t WS_R0 = 0;
constexpr size_t WS_R1 = 128 * MiB;
constexpr size_t WS_R2 = 224 * MiB;
constexpr size_t WS_R3 = 320 * MiB;
constexpr size_t WS_W  = 416 * MiB;
constexpr size_t WS_END = 460 * MiB;

struct Params {
    const float *x_prompt, *x_sample, *w_in, *rate_f, *rate_b, *gn_g, *conv_w, *w_out, *ln1_g, *ln1_b, *w_query, *keys1, *keys2, *peer_u, *peer_v, *ln2_g, *ln2_b;
    float* out; unsigned char* ws;
};

DI unsigned pk2(float a, float b) { f32x2_t v = {a, b}; return __builtin_bit_cast(unsigned, __builtin_convertvector(v, bf16x2_t)); }
DI float bf_lo(unsigned w) { return __uint_as_float(w << 16); }
DI float bf_hi(unsigned w) { return __uint_as_float(w & 0xffff0000u); }
DI f32x4 mfma16(bf16x8 a, bf16x8 b, f32x4 c) { return __builtin_amdgcn_mfma_f32_16x16x32_bf16(a, b, c, 0, 0, 0); }
DI float wave_sum(float x) { x += __shfl_xor(x, 1); x += __shfl_xor(x, 2); x += __shfl_xor(x, 4); x += __shfl_xor(x, 8); x += __shfl_xor(x, 16); x += __shfl_xor(x, 32); return x; }
DI float dot2bf(unsigned a, unsigned b, float c) { return __builtin_amdgcn_fdot2_f32_bf16(__builtin_bit_cast(bf16x2_t, a), __builtin_bit_cast(bf16x2_t, b), c, false); }
DI const float* xrow(const Params& p, int tok) { return tok < 8192 ? p.x_prompt + (size_t)tok * DM : p.x_sample + (size_t)(tok - 8192) * DM; }

DI int map_inproj(int c) {
    if (c < 2048) { const int blk = c >> 7, cc = c & 127, g = cc >> 3, j = cc & 7; return blk * 128 + 4 * g + (j & 3) + 64 * (j >> 2); }
    if (c < 4096) return c;
    if (c < 6144) { const int t = (c - 4096) >> 8, wi = (c - 4096) & 255, half = wi >> 7, col = wi & 127; return (half ? 6144 : 4096) + 128 * t + col; }
    return 5120 + (c - 6144);
}
template <bool MAPPED> DI void transpose_convert(const float* __restrict__ src, int ld, bf16_t* __restrict__ dst, int N, int bid, int nb) {
    const int lane = threadIdx.x & 63, w = threadIdx.x >> 6, nch = N / 256;
    for (int it = bid; it < nch * 32; it += nb) {
        const int chi = it % nch, k8hi = it / nch, c = chi * 256 + lane * 4, k8 = k8hi * 8 + w;
        const int sc = MAPPED ? map_inproj(c) : c;
        const float* sp = src + (size_t)(k8 * 8) * ld + sc;
        f32x4 v[8];
#pragma unroll
        for (int i = 0; i < 8; ++i) v[i] = *(const f32x4*)(sp + (size_t)i * ld);
#pragma unroll
        for (int cc = 0; cc < 4; ++cc) {
            u32x4 o; o.x = pk2(v[0][cc], v[1][cc]); o.y = pk2(v[2][cc], v[3][cc]); o.z = pk2(v[4][cc], v[5][cc]); o.w = pk2(v[6][cc], v[7][cc]);
            *(u32x4*)(dst + (size_t)(c + cc) * 2048 + k8 * 8) = o;
        }
    }
}
DI void convert_flat(const float* __restrict__ src, bf16_t* __restrict__ dst, size_t n8, int bid, int nb) {
    for (size_t i = (size_t)bid * 512 + threadIdx.x; i < n8; i += (size_t)nb * 512) {
        const float4 a = *(const float4*)(src + i * 8), b = *(const float4*)(src + i * 8 + 4);
        u32x4 o; o.x = pk2(a.x, a.y); o.y = pk2(a.z, a.w); o.z = pk2(b.x, b.y); o.w = pk2(b.z, b.w);
        *(u32x4*)(dst + i * 8) = o;
    }
}
DI void fold_phase(const float* __restrict__ wq, const float* __restrict__ k1, const float* __restrict__ k2, bf16_t* __restrict__ WqkT, unsigned char* lds, int bid, int nb) {
    float* sK = (float*)lds; float* sW = sK + 128 * 132;
    const int tid = threadIdx.x;
    for (int it = bid; it < 512; it += nb) {
        const int hh = it >> 5, kt = it & 31, head = hh >> 1, half = hh & 1;
        const float* keys = (half ? k2 : k1) + (size_t)head * 16384;
        __syncthreads();
        for (int p = tid; p < 4096; p += 512) { const int n = p >> 5, d4 = p & 31; *(float4*)(sK + n * 132 + d4 * 4) = *(const float4*)(keys + n * 128 + d4 * 4); }
        for (int p = tid; p < 2048; p += 512) { const int kk = p >> 5, d4 = p & 31; *(float4*)(sW + kk * 132 + d4 * 4) = *(const float4*)(wq + (size_t)(kt * 64 + kk) * 2048 + hh * 128 + d4 * 4); }
        __syncthreads();
        const int n = tid & 63, kq = tid >> 6;
        float acc0[8], acc1[8];
#pragma unroll
        for (int i = 0; i < 8; ++i) { acc0[i] = 0.f; acc1[i] = 0.f; }
        for (int d4 = 0; d4 < 32; ++d4) {
            const float4 ka = *(const float4*)(sK + n * 132 + d4 * 4), kb = *(const float4*)(sK + (n + 64) * 132 + d4 * 4);
#pragma unroll
            for (int i = 0; i < 8; ++i) { const float4 wv = *(const float4*)(sW + (kq * 8 + i) * 132 + d4 * 4);
                acc0[i] += ka.x * wv.x + ka.y * wv.y + ka.z * wv.z + ka.w * wv.w; acc1[i] += kb.x * wv.x + kb.y * wv.y + kb.z * wv.z + kb.w * wv.w; }
        }
        bf16_t* dst = WqkT + (size_t)(hh * 128 + n) * 2048 + kt * 64 + kq * 8;
        u32x4 o0, o1; o0.x = pk2(acc0[0], acc0[1]); o0.y = pk2(acc0[2], acc0[3]); o0.z = pk2(acc0[4], acc0[5]); o0.w = pk2(acc0[6], acc0[7]);
        o1.x = pk2(acc1[0], acc1[1]); o1.y = pk2(acc1[2], acc1[3]); o1.z = pk2(acc1[4], acc1[5]); o1.w = pk2(acc1[6], acc1[7]);
        *(u32x4*)dst = o0; *(u32x4*)(dst + (size_t)64 * 2048) = o1;
    }
}

struct EpiInProj {
    static constexpr bool PERM = true, AFTER_DRAIN = false;
    bf16_t *Q, *U, *BG;
    __device__ __forceinline__ void operator()(const f32x4 (&acc)[2][2][4][2], const pg8::Unit& u, int wr, int wc, int fr, int fq) const {
        const int pn = u.pn, row0 = u.pm * 256 + wr * 64 + fr, cl = wc * 32 + 8 * fq;
        if (pn < 8) {
            bf16_t* dst = Q + (size_t)(pn >> 2) * ((size_t)TOK * RW); const float sc = pn < 4 ? 1.0f : 0.08838834764831845f; const int colbase = (pn & 3) * 256 + cl;
            float cf[4];
#pragma unroll
            for (int e = 0; e < 4; ++e) cf[e] = exp2f(-(float)(cl / 2 + e) * 0.20762050593046014f) * 0.15915494309189535f;
#pragma unroll
            for (int ai = 0; ai < 2; ++ai)
#pragma unroll
                for (int m = 0; m < 4; ++m) {
                    const int row = row0 + ai * 128 + m * 16; const float pos = (float)(row & 8191);
                    float cs[4], sn[4];
#pragma unroll
                    for (int e = 0; e < 4; ++e) { const float pp = pos * cf[e], er = fmaf(pos, cf[e], -pp), frv = (pp - floorf(pp)) + er; sn[e] = __builtin_amdgcn_sinf(frv); cs[e] = __builtin_amdgcn_cosf(frv); }
#pragma unroll
                    for (int bj = 0; bj < 2; ++bj) {
                        const f32x4 x1 = acc[ai][bj][m][0], x2 = acc[ai][bj][m][1]; float o1[4], o2[4];
#pragma unroll
                        for (int e = 0; e < 4; ++e) { o1[e] = (x1[e] * cs[e] - x2[e] * sn[e]) * sc; o2[e] = (x1[e] * sn[e] + x2[e] * cs[e]) * sc; }
                        u32x4 w; w.x = pk2(o1[0], o1[1]); w.y = pk2(o1[2], o1[3]); w.z = pk2(o2[0], o2[1]); w.w = pk2(o2[2], o2[3]);
                        *(u32x4*)(dst + (size_t)row * RW + colbase + bj * 128) = w;
                    }
                }
        } else if (pn < 16 || pn >= 24) {
            bf16_t* dst = pn < 16 ? Q + (size_t)(pn >> 2) * ((size_t)TOK * RW) : BG; const int colbase = (pn & 3) * 256 + cl; const bool is_gate = pn >= 12 && pn < 16;
#pragma unroll
            for (int ai = 0; ai < 2; ++ai)
#pragma unroll
                for (int m = 0; m < 4; ++m) {
                    const int row = row0 + ai * 128 + m * 16;
#pragma unroll
                    for (int bj = 0; bj < 2; ++bj) {
                        f32x4 v0 = acc[ai][bj][m][0], v1 = acc[ai][bj][m][1];
                        if (is_gate) {
#pragma unroll
                            for (int e = 0; e < 4; ++e) { v0[e] = v0[e] * __builtin_amdgcn_rcpf(1.0f + __builtin_amdgcn_exp2f(-v0[e] * LOG2E)); v1[e] = v1[e] * __builtin_amdgcn_rcpf(1.0f + __builtin_amdgcn_exp2f(-v1[e] * LOG2E)); }
                        }
                        u32x4 w; w.x = pk2(v0[0], v0[1]); w.y = pk2(v0[2], v0[3]); w.z = pk2(v1[0], v1[1]); w.w = pk2(v1[2], v1[3]);
                        *(u32x4*)(dst + (size_t)row * RW + colbase + bj * 128) = w;
                    }
                }
        } else {
            const int colbase = (pn - 16) * 128 + cl;
#pragma unroll
            for (int ai = 0; ai < 2; ++ai)
#pragma unroll
                for (int m = 0; m < 4; ++m) {
                    const int row = row0 + ai * 128 + m * 16;
                    const f32x4 v0 = acc[ai][0][m][0] * acc[ai][1][m][0], v1 = acc[ai][0][m][1] * acc[ai][1][m][1];
                    u32x4 w; w.x = pk2(v0[0], v0[1]); w.y = pk2(v0[2], v0[3]); w.z = pk2(v1[0], v1[1]); w.w = pk2(v1[2], v1[3]);
                    *(u32x4*)(U + (size_t)row * RW + colbase) = w;
                }
        }
    }
};
struct EpiOutProj {
    static constexpr bool PERM = true, AFTER_DRAIN = false;
    bf16_t* Z;
    __device__ __forceinline__ void operator()(const f32x4 (&acc)[2][2][4][2], const pg8::Unit& u, int wr, int wc, int fr, int fq) const {
        const int row0 = u.pm * 256 + wr * 64 + fr, col0 = u.pn * 256 + wc * 32 + 8 * fq;
#pragma unroll
        for (int ai = 0; ai < 2; ++ai)
#pragma unroll
            for (int m = 0; m < 4; ++m) {
                const int row = row0 + ai * 128 + m * 16;
#pragma unroll
                for (int bj = 0; bj < 2; ++bj) {
                    const f32x4 v0 = acc[ai][bj][m][0], v1 = acc[ai][bj][m][1];
                    u32x4 w; w.x = pk2(v0[0], v0[1]); w.y = pk2(v0[2], v0[3]); w.z = pk2(v1[0], v1[1]); w.w = pk2(v1[2], v1[3]);
                    *(u32x4*)(Z + (size_t)row * DM + col0 + bj * 128) = w;
                }
            }
    }
};
struct EpiScore {
    static constexpr bool PERM = true, AFTER_DRAIN = false;
    bf16_t* C;
    __device__ __forceinline__ void operator()(const f32x4 (&acc)[2][2][4][2], const pg8::Unit& u, int wr, int wc, int fr, int fq) const {
        const int row0 = u.pm * 256 + wr * 64 + fr, col0 = u.pn * 256 + wc * 32 + 8 * fq;
#pragma unroll
        for (int ai = 0; ai < 2; ++ai)
#pragma unroll
            for (int m = 0; m < 4; ++m) {
                const int row = row0 + ai * 128 + m * 16;
#pragma unroll
                for (int bj = 0; bj < 2; ++bj) {
                    const f32x4 v0 = acc[ai][bj][m][0], v1 = acc[ai][bj][m][1];
                    u32x4 w; w.x = pk2(v0[0], v0[1]); w.y = pk2(v0[2], v0[3]); w.z = pk2(v1[0], v1[1]); w.w = pk2(v1[2], v1[3]);
                    *(u32x4*)(C + (size_t)row * DM + col0 + bj * 128) = w;
                }
            }
    }
};

DI unsigned tile_off(int r, int j) { return (unsigned)(r * 256 + ((((j >> 3) ^ (r & 15))) << 4) + (j & 7) * 2); }
template <int E> DI unsigned short bfel(const u32x4& v) { const unsigned w = v[E >> 1]; return (unsigned short)((E & 1) ? (w >> 16) : (w & 0xffffu)); }
template <int E> DI float bfelf(const u32x4& v) { const unsigned w = v[E >> 1]; return (E & 1) ? bf_hi(w) : bf_lo(w); }

DI void r1_phase(const bf16_t* __restrict__ K, const bf16_t* __restrict__ V, bf16_t* __restrict__ KVf, bf16_t* __restrict__ KVb, const float* rate_f, const float* rate_b,
                 unsigned char* lds, int bid, int nb) {
    const int tid = threadIdx.x, lane = tid & 63, w = tid >> 6, m16 = lane & 15, quad = lane >> 4;
    unsigned char* sKf = lds; unsigned char* sKb = lds + 32768; unsigned char* sV = lds + 65536;
    for (int item = bid; item < 1536; item += nb) {
        const int hd = item & 7; const size_t T0 = (size_t)(item >> 3) * 128;
        const float lgf = -__expf(rate_f[hd]) * LOG2E, lgb = -__expf(rate_b[hd]) * LOG2E;
        __syncthreads();
#pragma unroll
        for (int i = 0; i < 2; ++i) {
            const int p = tid + 512 * i, j = (p >> 4) * 2, d8 = p & 15;
            const bf16_t* kp = K + (T0 + j) * RW + hd * 128 + d8 * 8; const bf16_t* vp = V + (T0 + j) * RW + hd * 128 + d8 * 8;
            const u32x4 k0 = *(const u32x4*)kp, k1 = *(const u32x4*)(kp + RW), v0 = *(const u32x4*)vp, v1 = *(const u32x4*)(vp + RW);
            const float zf0 = exp2f(lgf * (float)(127 - j)), zf1 = exp2f(lgf * (float)(126 - j)), zb0 = exp2f(lgb * (float)j), zb1 = exp2f(lgb * (float)(j + 1));
#define R1_EL(E) { const int d = d8 * 8 + E; const unsigned off = tile_off(d, j); const float ka = bfelf<E>(k0), kb = bfelf<E>(k1); \
                *(unsigned*)(sKf + off) = pk2(ka * zf0, kb * zf1); *(unsigned*)(sKb + off) = pk2(ka * zb0, kb * zb1); \
                *(unsigned*)(sV + off) = (unsigned)bfel<E>(v0) | ((unsigned)bfel<E>(v1) << 16); }
            R1_EL(0) R1_EL(1) R1_EL(2) R1_EL(3) R1_EL(4) R1_EL(5) R1_EL(6) R1_EL(7)
#undef R1_EL
        }
        __syncthreads();
        f32x4 af[8], ab[8];
#pragma unroll
        for (int mt = 0; mt < 8; ++mt) { af[mt] = (f32x4){0.f, 0.f, 0.f, 0.f}; ab[mt] = (f32x4){0.f, 0.f, 0.f, 0.f}; }
#pragma unroll
        for (int ks = 0; ks < 4; ++ks) {
            const int vr = 16 * w + m16;
            const bf16x8 bv = *(const bf16x8*)(sV + vr * 256 + ((((4 * ks + quad) ^ (vr & 15))) << 4));
#pragma unroll
            for (int mt = 0; mt < 8; ++mt) {
                const int r = 16 * mt + m16; const unsigned o = r * 256 + ((((4 * ks + quad) ^ (r & 15))) << 4);
                const bf16x8 a_f = *(const bf16x8*)(sKf + o), a_b = *(const bf16x8*)(sKb + o);
                af[mt] = mfma16(a_f, bv, af[mt]); ab[mt] = mfma16(a_b, bv, ab[mt]);
            }
        }
        const size_t ob = (size_t)item * 16384 + (size_t)(16 * w + m16) * 128 + 4 * quad;
#pragma unroll
        for (int mt = 0; mt < 8; ++mt) {
            u32x2 a; a.x = pk2(af[mt][0], af[mt][1]); a.y = pk2(af[mt][2], af[mt][3]); *(u32x2*)(KVf + ob + 16 * mt) = a;
            u32x2 b; b.x = pk2(ab[mt][0], ab[mt][1]); b.y = pk2(ab[mt][2], ab[mt][3]); *(u32x2*)(KVb + ob + 16 * mt) = b;
        }
    }
}

DI void r2_phase(const bf16_t* __restrict__ KVf, const bf16_t* __restrict__ KVb, bf16_t* __restrict__ Sf, bf16_t* __restrict__ Sb, const float* rate_f, const float* rate_b, int bid, int nb) {
    for (int g = bid * 512 + threadIdx.x; g < 98304; g += nb * 512) {
        const int dir = g / 49152, rem = g % 49152, sh = rem >> 11, piece = rem & 2047, s = sh >> 3, hd = sh & 7;
        const float lg = -__expf((dir ? rate_b : rate_f)[hd]) * LOG2E, Gc = exp2f(lg * 128.f);
        const bf16_t* src = dir ? KVb : KVf; bf16_t* dst = dir ? Sb : Sf;
        float st[8];
#pragma unroll
        for (int e = 0; e < 8; ++e) st[e] = 0.f;
        for (int cc = 0; cc < 64; ++cc) {
            const int c = dir ? 63 - cc : cc;
            const size_t off = ((size_t)((s * 64 + c) * 8 + hd)) * 16384 + (size_t)piece * 8;
            const u32x4 kv = *(const u32x4*)(src + off);
            u32x4 o; o.x = pk2(st[0], st[1]); o.y = pk2(st[2], st[3]); o.z = pk2(st[4], st[5]); o.w = pk2(st[6], st[7]);
            *(u32x4*)(dst + off) = o;
            st[0] = st[0] * Gc + bf_lo(kv.x); st[1] = st[1] * Gc + bf_hi(kv.x); st[2] = st[2] * Gc + bf_lo(kv.y); st[3] = st[3] * Gc + bf_hi(kv.y);
            st[4] = st[4] * Gc + bf_lo(kv.z); st[5] = st[5] * Gc + bf_hi(kv.z); st[6] = st[6] * Gc + bf_lo(kv.w); st[7] = st[7] * Gc + bf_hi(kv.w);
        }
    }
}

DI float silu_f(float x) { return x * __builtin_amdgcn_rcpf(1.0f + __builtin_amdgcn_exp2f(-x * LOG2E)); }

DI void r3_phase(const bf16_t* __restrict__ Q, const bf16_t* __restrict__ K, const bf16_t* __restrict__ V, const bf16_t* __restrict__ G, const bf16_t* __restrict__ Sf, const bf16_t* __restrict__ Sb,
                 const float* rate_f, const float* rate_b, const float* __restrict__ gn_g, bf16_t* __restrict__ mix, unsigned char* lds, int bid, int nb) {
    const int tid = threadIdx.x, lane = tid & 63, w = tid >> 6, m16 = lane & 15, quad = lane >> 4;
    unsigned char* sV = lds; unsigned char* sK = lds + 32768; unsigned char* sSf = lds + 65536; unsigned char* sSb = lds + 98304;
    for (int item = bid; item < 1536; item += nb) {
        const int hd = item & 7; const size_t T0 = (size_t)(item >> 3) * 128;
        const float lgf = -__expf(rate_f[hd]) * LOG2E, lgb = -__expf(rate_b[hd]) * LOG2E;
        __syncthreads();
#pragma unroll
        for (int i = 0; i < 4; ++i) {
            const int p = tid + 512 * i, r = p >> 4, c16 = p & 15;
            const unsigned o = (unsigned)(r * 256 + ((c16 ^ (r & 15)) << 4));
            *(u32x4*)(sK + o) = *(const u32x4*)(K + (T0 + r) * RW + hd * 128 + c16 * 8);
            *(u32x4*)(sSf + o) = *(const u32x4*)(Sf + (size_t)item * 16384 + r * 128 + c16 * 8);
            *(u32x4*)(sSb + o) = *(const u32x4*)(Sb + (size_t)item * 16384 + r * 128 + c16 * 8);
        }
#pragma unroll
        for (int i = 0; i < 2; ++i) {
            const int p = tid + 512 * i, j = (p >> 4) * 2, d8 = p & 15;
            const bf16_t* vp = V + (T0 + j) * RW + hd * 128 + d8 * 8;
            const u32x4 v0 = *(const u32x4*)vp, v1 = *(const u32x4*)(vp + RW);
#define R3_EL(E) { *(unsigned*)(sV + tile_off(d8 * 8 + E, j)) = (unsigned)bfel<E>(v0) | ((unsigned)bfel<E>(v1) << 16); }
            R3_EL(0) R3_EL(1) R3_EL(2) R3_EL(3) R3_EL(4) R3_EL(5) R3_EL(6) R3_EL(7)
#undef R3_EL
        }
        const int il = 16 * w + m16;
        const size_t tq = T0 + il;
        bf16x8 bq[4];
#pragma unroll
        for (int ks = 0; ks < 4; ++ks) bq[ks] = *(const bf16x8*)(Q + tq * RW + hd * 128 + 32 * ks + 8 * quad);
        __syncthreads();
        f32x4 aS[8];
#pragma unroll
        for (int mt = 0; mt < 8; ++mt) aS[mt] = (f32x4){0.f, 0.f, 0.f, 0.f};
#pragma unroll
        for (int ks = 0; ks < 4; ++ks)
#pragma unroll
            for (int mt = 0; mt < 8; ++mt) {
                const int r = 16 * mt + m16;
                const bf16x8 ak = *(const bf16x8*)(sK + r * 256 + ((((4 * ks + quad) ^ (r & 15))) << 4));
                aS[mt] = mfma16(ak, bq[ks], aS[mt]);
            }
        bf16x8 bp[4];
#pragma unroll
        for (int s = 0; s < 4; ++s) {
            float pv[8];
#pragma unroll
            for (int t = 0; t < 8; ++t) {
                const int mt = 2 * s + (t >> 2), r = t & 3, j = 16 * mt + 4 * quad + r, dl = il - j;
                const float dec = dl > 0 ? __builtin_amdgcn_exp2f(lgf * (float)dl) : (dl < 0 ? __builtin_amdgcn_exp2f(lgb * (float)(-dl)) : 2.0f);
                pv[t] = aS[mt][r] * dec;
            }
            u32x4 pk; pk.x = pk2(pv[0], pv[1]); pk.y = pk2(pv[2], pv[3]); pk.z = pk2(pv[4], pv[5]); pk.w = pk2(pv[6], pv[7]);
            bp[s] = __builtin_bit_cast(bf16x8, pk);
        }
        f32x4 aO[8];
#pragma unroll
        for (int mt = 0; mt < 8; ++mt) aO[mt] = (f32x4){0.f, 0.f, 0.f, 0.f};
#pragma unroll
        for (int s = 0; s < 4; ++s)
#pragma unroll
            for (int mt = 0; mt < 8; ++mt) {
                const int row = 16 * mt + m16;
                const u32x2 lo = *(const u32x2*)(sV + row * 256 + ((((4 * s + (quad >> 1)) ^ (row & 15))) << 4) + (quad & 1) * 8);
                const u32x2 hi = *(const u32x2*)(sV + row * 256 + ((((4 * s + 2 + (quad >> 1)) ^ (row & 15))) << 4) + (quad & 1) * 8);
                u32x4 av; av.x = lo.x; av.y = lo.y; av.z = hi.x; av.w = hi.y;
                aO[mt] = mfma16(__builtin_bit_cast(bf16x8, av), bp[s], aO[mt]);
            }
#pragma unroll
        for (int dir = 0; dir < 2; ++dir) {
            const unsigned char* sS = dir ? sSb : sSf;
            f32x4 aX[8];
#pragma unroll
            for (int mt = 0; mt < 8; ++mt) aX[mt] = (f32x4){0.f, 0.f, 0.f, 0.f};
#pragma unroll
            for (int ks = 0; ks < 4; ++ks)
#pragma unroll
                for (int mt = 0; mt < 8; ++mt) {
                    const int r = 16 * mt + m16;
                    const bf16x8 a = *(const bf16x8*)(sS + r * 256 + ((((4 * ks + quad) ^ (r & 15))) << 4));
                    aX[mt] = mfma16(a, bq[ks], aX[mt]);
                }
            const float xi = dir ? exp2f(lgb * (float)(128 - il)) : exp2f(lgf * (float)(il + 1));
#pragma unroll
            for (int mt = 0; mt < 8; ++mt) aO[mt] += xi * aX[mt];
        }
        float sum = 0.f;
#pragma unroll
        for (int mt = 0; mt < 8; ++mt) sum += (aO[mt][0] + aO[mt][1]) + (aO[mt][2] + aO[mt][3]);
        sum += __shfl_xor(sum, 16); sum += __shfl_xor(sum, 32);
        const float mu = sum * (1.0f / 128.0f); float qv = 0.f;
#pragma unroll
        for (int mt = 0; mt < 8; ++mt) { const f32x4 d = aO[mt] - mu; qv += (d[0] * d[0] + d[1] * d[1]) + (d[2] * d[2] + d[3] * d[3]); }
        qv += __shfl_xor(qv, 16); qv += __shfl_xor(qv, 32);
        const float rstd = rsqrtf(qv * (1.0f / 128.0f) + 1e-6f);
#pragma unroll
        for (int mt = 0; mt < 8; ++mt) {
            const int dv0 = 16 * mt + 4 * quad;
            const u32x2 gg = *(const u32x2*)(G + tq * RW + hd * 128 + dv0); const f32x4 gn = *(const f32x4*)(gn_g + hd * 128 + dv0);
            const float o0 = (aO[mt][0] - mu) * rstd * gn[0] * bf_lo(gg.x), o1 = (aO[mt][1] - mu) * rstd * gn[1] * bf_hi(gg.x);
            const float o2 = (aO[mt][2] - mu) * rstd * gn[2] * bf_lo(gg.y), o3 = (aO[mt][3] - mu) * rstd * gn[3] * bf_hi(gg.y);
            u32x2 o; o.x = pk2(o0, o1); o.y = pk2(o2, o3);
            *(u32x2*)(mix + tq * DM + hd * 128 + dv0) = o;
        }
    }
}

DI void conv_phase(const bf16_t* __restrict__ U, const bf16_t* __restrict__ BG, const float* __restrict__ cw, bf16_t* __restrict__ mix, int bid, int nb) {
    for (size_t i = (size_t)bid * 512 + threadIdx.x; i < (size_t)TOK * 128; i += (size_t)nb * 512) {
        const size_t t = i >> 7; const int c8 = (int)(i & 127) * 8, pos = (int)(t & 8191);
        const u32x4 zero = {0u, 0u, 0u, 0u};
        const u32x4 u1 = *(const u32x4*)(U + t * RW + c8);
        const u32x4 u0 = pos > 0 ? *(const u32x4*)(U + (t - 1) * RW + c8) : zero;
        const u32x4 u2 = pos < 8191 ? *(const u32x4*)(U + (t + 1) * RW + c8) : zero;
        const u32x4 bg = *(const u32x4*)(BG + t * RW + c8);
        const f32x4 w0a = *(const f32x4*)(cw + c8), w0b = *(const f32x4*)(cw + c8 + 4), w1a = *(const f32x4*)(cw + 1024 + c8), w1b = *(const f32x4*)(cw + 1024 + c8 + 4),
                    w2a = *(const f32x4*)(cw + 2048 + c8), w2b = *(const f32x4*)(cw + 2048 + c8 + 4);
        float r[8];
#define CV(E, WA, IDX) r[E] = bfelf<E>(bg) * (WA##0[IDX] * bfelf<E>(u0) + WA##1[IDX] * bfelf<E>(u1) + WA##2[IDX] * bfelf<E>(u2));
        { const f32x4 A0 = w0a, A1 = w1a, A2 = w2a, B0 = w0b, B1 = w1b, B2 = w2b;
          CV(0, A, 0) CV(1, A, 1) CV(2, A, 2) CV(3, A, 3) CV(4, B, 0) CV(5, B, 1) CV(6, B, 2) CV(7, B, 3) }
#undef CV
        u32x4 o; o.x = pk2(r[0], r[1]); o.y = pk2(r[2], r[3]); o.z = pk2(r[4], r[5]); o.w = pk2(r[6], r[7]);
        *(u32x4*)(mix + t * DM + 1024 + c8) = o;
    }
}

DI void ln1_phase(const bf16_t* __restrict__ Z, const bf16_t* __restrict__ X, const float* __restrict__ g, const float* __restrict__ b, bf16_t* __restrict__ H, int bid, int nb) {
    const int lane = threadIdx.x & 63, w = threadIdx.x >> 6;
    for (int row = bid * 8 + w; row < TOK; row += nb * 8) {
        u32x4 zv[4], xv[4]; float v[32];
#pragma unroll
        for (int i = 0; i < 4; ++i) { zv[i] = *(const u32x4*)(Z + (size_t)row * DM + (lane + 64 * i) * 8); xv[i] = *(const u32x4*)(X + (size_t)row * DM + (lane + 64 * i) * 8); }
        float s = 0.f;
#pragma unroll
        for (int i = 0; i < 4; ++i)
#pragma unroll
            for (int k = 0; k < 4; ++k) { v[8 * i + 2 * k] = bf_lo(zv[i][k]) + ALPHA * bf_lo(xv[i][k]); v[8 * i + 2 * k + 1] = bf_hi(zv[i][k]) + ALPHA * bf_hi(xv[i][k]); s += v[8 * i + 2 * k] + v[8 * i + 2 * k + 1]; }
        s = wave_sum(s); const float mu = s * (1.0f / 2048.0f); float q = 0.f;
#pragma unroll
        for (int k = 0; k < 32; ++k) { const float d = v[k] - mu; q += d * d; }
        q = wave_sum(q); const float rstd = rsqrtf(q * (1.0f / 2048.0f) + 1e-5f);
#pragma unroll
        for (int i = 0; i < 4; ++i) {
            const int c0 = (lane + 64 * i) * 8;
            const f32x4 ga = *(const f32x4*)(g + c0), gb = *(const f32x4*)(g + c0 + 4), ba = *(const f32x4*)(b + c0), bb = *(const f32x4*)(b + c0 + 4);
            u32x4 o;
            o.x = pk2((v[8 * i + 0] - mu) * rstd * ga[0] + ba[0], (v[8 * i + 1] - mu) * rstd * ga[1] + ba[1]);
            o.y = pk2((v[8 * i + 2] - mu) * rstd * ga[2] + ba[2], (v[8 * i + 3] - mu) * rstd * ga[3] + ba[3]);
            o.z = pk2((v[8 * i + 4] - mu) * rstd * gb[0] + bb[0], (v[8 * i + 5] - mu) * rstd * gb[1] + bb[1]);
            o.w = pk2((v[8 * i + 6] - mu) * rstd * gb[2] + bb[2], (v[8 * i + 7] - mu) * rstd * gb[3] + bb[3]);
            *(u32x4*)(H + (size_t)row * DM + c0) = o;
        }
    }
}


DI void table_fp4_phase(const float* __restrict__ src, unsigned char* __restrict__ dst, float* __restrict__ scale, int bid, int nb, int row_begin = 0, int row_end = 16384) {
    const int lane = threadIdx.x & 63, w = threadIdx.x >> 6;
    for (int row = row_begin + bid * 8 + w; row < row_end; row += nb * 8) {
        f32x4 v[8]; float am = 0.f;
#pragma unroll
        for (int k = 0; k < 8; ++k) { v[k] = *(const f32x4*)(src + (size_t)row * DM + lane * 32 + 4 * k);
            am = fmaxf(am, fmaxf(fmaxf(fabsf(v[k][0]), fabsf(v[k][1])), fmaxf(fabsf(v[k][2]), fabsf(v[k][3])))); }
        am = fmaxf(am, __shfl_xor(am, 1)); am = fmaxf(am, __shfl_xor(am, 2)); am = fmaxf(am, __shfl_xor(am, 4)); am = fmaxf(am, __shfl_xor(am, 8)); am = fmaxf(am, __shfl_xor(am, 16)); am = fmaxf(am, __shfl_xor(am, 32));
        const float sc = am > 0.f ? am * (0.8f / 6.0f) : 1.0f, inv = 1.0f / sc;
        if (lane == 0) scale[row] = sc;
        u32x4 o;
#pragma unroll
        for (int k = 0; k < 4; ++k) {
            unsigned wd = 0;
            wd = __builtin_amdgcn_cvt_scalef32_pk_fp4_f32(wd, v[2 * k][0] * inv, v[2 * k][1] * inv, 1.0f, 0);
            wd = __builtin_amdgcn_cvt_scalef32_pk_fp4_f32(wd, v[2 * k][2] * inv, v[2 * k][3] * inv, 1.0f, 1);
            wd = __builtin_amdgcn_cvt_scalef32_pk_fp4_f32(wd, v[2 * k + 1][0] * inv, v[2 * k + 1][1] * inv, 1.0f, 2);
            wd = __builtin_amdgcn_cvt_scalef32_pk_fp4_f32(wd, v[2 * k + 1][2] * inv, v[2 * k + 1][3] * inv, 1.0f, 3);
            o[k] = wd;
        }
        *(u32x4*)(dst + ((size_t)(lane >> 3) * 16384 + row) * 128 + (lane & 7) * 16) = o;
    }
}

#define INS16(r, x) { _Pragma("unroll") for (int j_ = 15; j_ >= 1; --j_) r[j_] = __builtin_amdgcn_fmed3f(r[j_ - 1], r[j_], x); r[0] = fmaxf(r[0], x); }
DI float gelu_f(float x) { return 0.5f * x * (1.0f + erff(x * 0.7071067811865476f)); }


DI void route_phase(const float* __restrict__ scores, int* __restrict__ sel_eid, float* __restrict__ sel_gate, unsigned char* lds, int bid, int nb) {
    const int full = nb * 512 < TOK * 8 ? nb * 512 : TOK * 8, rest = TOK * 8 - full;
    int pb = rest > 0 ? (rest + nb - 1) / nb : 0; if (pb > 512) pb = 512;
    for (int seg = 0; seg < 2; ++seg)
    for (int row = seg == 0 ? bid * 512 + (int)threadIdx.x : ((int)threadIdx.x < pb ? full + bid * pb + (int)threadIdx.x : TOK * 8); row < (seg == 0 ? full : TOK * 8); row += (seg == 0 ? nb * 512 : nb * pb)) {
        const size_t tok = (size_t)(row >> 3); const int head = row & 7;
        const u32x4* sp = (const u32x4*)((const bf16_t*)scores + tok * DM + head * 256);
        float r1[16], r2[16];
#pragma unroll
        for (int j = 0; j < 16; ++j) { r1[j] = -INFINITY; r2[j] = -INFINITY; }
#define RT_INS(R, W, IDX) { const float lo_ = __uint_as_float(((W) << 16) | (unsigned)(IDX)), hi_ = __uint_as_float(((W) & 0xffff0000u) | (unsigned)((IDX) + 1)); INS16(R, lo_) INS16(R, hi_) }
        for (int i8 = 0; i8 < 2; ++i8) {
            u32x4 a[8];
#pragma unroll
            for (int q = 0; q < 8; ++q) a[q] = sp[8 * i8 + q];
#pragma unroll
            for (int q = 0; q < 8; ++q) { const int b8 = 8 * (8 * i8 + q); RT_INS(r1, a[q].x, b8) RT_INS(r1, a[q].y, b8 + 2) RT_INS(r1, a[q].z, b8 + 4) RT_INS(r1, a[q].w, b8 + 6) }
        }
        for (int i8 = 0; i8 < 2; ++i8) {
            u32x4 a[8];
#pragma unroll
            for (int q = 0; q < 8; ++q) a[q] = sp[16 + 8 * i8 + q];
#pragma unroll
            for (int q = 0; q < 8; ++q) { const int b8 = 8 * (8 * i8 + q); RT_INS(r2, a[q].x, b8) RT_INS(r2, a[q].y, b8 + 2) RT_INS(r2, a[q].z, b8 + 4) RT_INS(r2, a[q].w, b8 + 6) }
        }
#undef RT_INS
        unsigned* sidx = (unsigned*)lds;
#pragma unroll
        for (int d = 0; d < 4; ++d) {
            sidx[d * 512 + threadIdx.x] = (__float_as_uint(r1[4 * d]) & 127u) | ((__float_as_uint(r1[4 * d + 1]) & 127u) << 8) | ((__float_as_uint(r1[4 * d + 2]) & 127u) << 16) | ((__float_as_uint(r1[4 * d + 3]) & 127u) << 24);
            sidx[(4 + d) * 512 + threadIdx.x] = (__float_as_uint(r2[4 * d]) & 127u) | ((__float_as_uint(r2[4 * d + 1]) & 127u) << 8) | ((__float_as_uint(r2[4 * d + 2]) & 127u) << 16) | ((__float_as_uint(r2[4 * d + 3]) & 127u) << 24);
        }
        float bk[16];
#pragma unroll
        for (int j = 0; j < 16; ++j) bk[j] = -INFINITY;
#pragma unroll
        for (int a = 0; a < 16; ++a)
#pragma unroll
            for (int b = 0; b < 16; ++b)
                if ((a + 1) * (b + 1) <= 16) {
                    const float ksum = __uint_as_float(__float_as_uint(r1[a]) & 0xffffff80u) + __uint_as_float(__float_as_uint(r2[b]) & 0xffffff80u);
                    const float key = __uint_as_float((__float_as_uint(ksum) & 0xffffff00u) | (unsigned)(a * 16 + b));
                    INS16(bk, key)
                }
        int bpay[16];
#pragma unroll
        for (int j = 0; j < 16; ++j) {
            const unsigned pos = __float_as_uint(bk[j]) & 255u, pa = pos >> 4, pb = pos & 15u;
            const unsigned i1 = (sidx[(pa >> 2) * 512 + threadIdx.x] >> (8 * (pa & 3))) & 127u, i2 = (sidx[(4 + (pb >> 2)) * 512 + threadIdx.x] >> (8 * (pb & 3))) & 127u;
            bpay[j] = (int)((i1 << 7) | i2);
        }
        float ex[16], ssum = 0.f;
#pragma unroll
        for (int j = 0; j < 16; ++j) { ex[j] = __expf(bk[j] - bk[0]); ssum += ex[j]; }
        const float inv = 1.0f / ssum;
        int* ed = sel_eid + tok * 128 + head * 16; float* gd = sel_gate + tok * 128 + head * 16;
#pragma unroll
        for (int j4 = 0; j4 < 4; ++j4) {
            *(int4*)(ed + 4 * j4) = make_int4(bpay[4 * j4], bpay[4 * j4 + 1], bpay[4 * j4 + 2], bpay[4 * j4 + 3]);
            *(float4*)(gd + 4 * j4) = make_float4(ex[4 * j4] * inv, ex[4 * j4 + 1] * inv, ex[4 * j4 + 2] * inv, ex[4 * j4 + 3] * inv);
        }
    }
}

template <int CTRL> DI float dpp_f(float x) { return __int_as_float(__builtin_amdgcn_update_dpp(0, __float_as_int(x), CTRL, 0xf, 0xf, false)); }
DI float sum8(float x) { x += dpp_f<0xB1>(x); x += dpp_f<0x4E>(x); x += dpp_f<0x141>(x); return x; }
#define FP4PAIR(wd, b) __builtin_amdgcn_cvt_scalef32_pk_f32_fp4((wd), 1.0f, (b))
DI void peerA_step(u32x4 (&cur)[16], u32x4 (&nxt)[16], const u32x4 (&hcur)[4], u32x4 (&hnxt)[4], int (&eidN)[16], const unsigned char* Ubase, unsigned loff,
                   const bf16_t* hn_ptr, const int* epnn, float* pp, bool do_store, int g, int j) {
#pragma unroll
    for (int i = 0; i < 16; ++i) nxt[i] = *(const u32x4*)(Ubase + (((unsigned)eidN[i] << 7) + loff));
#pragma unroll
    for (int k = 0; k < 4; ++k) hnxt[k] = (*(const u32x4*)(hn_ptr + 8 * k));
#pragma unroll
    for (int i = 0; i < 16; ++i) eidN[i] = (*(epnn + 8 * i));
    unsigned hw[16];
#pragma unroll
    for (int k = 0; k < 4; ++k) { hw[4 * k] = hcur[k].x; hw[4 * k + 1] = hcur[k].y; hw[4 * k + 2] = hcur[k].z; hw[4 * k + 3] = hcur[k].w; }
#pragma unroll
    for (int q = 0; q < 16; ++q) asm volatile("" : "+v"(hw[q]));
    float part[16];
#pragma unroll
    for (int i = 0; i < 16; ++i) {
        float a = 0.f;
#pragma unroll
        for (int k = 0; k < 4; ++k) {
            a = __builtin_amdgcn_fdot2_f32_bf16(__builtin_amdgcn_cvt_scalef32_pk_bf16_fp4(cur[i][k], 1.0f, 0), __builtin_bit_cast(bf16x2_t, hw[4 * k + 0]), a, false);
            a = __builtin_amdgcn_fdot2_f32_bf16(__builtin_amdgcn_cvt_scalef32_pk_bf16_fp4(cur[i][k], 1.0f, 1), __builtin_bit_cast(bf16x2_t, hw[4 * k + 1]), a, false);
            a = __builtin_amdgcn_fdot2_f32_bf16(__builtin_amdgcn_cvt_scalef32_pk_bf16_fp4(cur[i][k], 1.0f, 2), __builtin_bit_cast(bf16x2_t, hw[4 * k + 2]), a, false);
            a = __builtin_amdgcn_fdot2_f32_bf16(__builtin_amdgcn_cvt_scalef32_pk_bf16_fp4(cur[i][k], 1.0f, 3), __builtin_bit_cast(bf16x2_t, hw[4 * k + 3]), a, false);
        }
        part[i] = a;
    }
    const bool b0 = (j & 1) != 0, b1 = (j & 2) != 0, b2 = (j & 4) != 0;
    float r8[8], r4[4], r2[2];
#pragma unroll
    for (int k = 0; k < 8; ++k) { const float keep = b0 ? part[8 + k] : part[k], send = b0 ? part[k] : part[8 + k]; r8[k] = keep + dpp_f<0xB1>(send); }
#pragma unroll
    for (int k = 0; k < 4; ++k) { const float keep = b1 ? r8[4 + k] : r8[k], send = b1 ? r8[k] : r8[4 + k]; r4[k] = keep + dpp_f<0x4E>(send); }
#pragma unroll
    for (int k = 0; k < 2; ++k) { const float keep = b2 ? r4[2 + k] : r4[k], send = b2 ? r4[k] : r4[2 + k]; r2[k] = keep + dpp_f<0x1B>(dpp_f<0x141>(send)); }
    const int i0 = (b0 ? 8 : 0) + (b1 ? 4 : 0) + (b2 ? 2 : 0);
    if (do_store) { __builtin_nontemporal_store(r2[0], pp + 8 * i0 + g); __builtin_nontemporal_store(r2[1], pp + 8 * i0 + 8 + g); }
}
DI void peerA_phase(const bf16_t* __restrict__ H, const unsigned char* __restrict__ U4, const int* __restrict__ sel_eid, float* __restrict__ P, int bid, int nb) {
    const int lane = threadIdx.x & 63, w = threadIdx.x >> 6, g = lane >> 3, j = lane & 7;
    const int s = bid & 7, nxb = nb >> 3;
    if ((bid >> 3) >= nxb) return;
    const int widx = (bid >> 3) * 8 + w, nw = nxb * 8;
    const int ntok = (TOK - widx + nw - 1) / nw;
    const size_t coff = (size_t)(256 * s + 32 * j); const unsigned char* Ubase = U4 + (size_t)s * (16384 * 128); const unsigned loff = 16u * j;
    int eidN[16]; u32x4 uvA[16], uvB[16]; u32x4 hA[4], hB[4];
    {   const int t0 = widx, t1 = ntok > 1 ? widx + nw : widx;
        const int* ep = sel_eid + (size_t)t0 * 128 + g;
#pragma unroll
        for (int i = 0; i < 16; ++i) eidN[i] = (*(ep + 8 * i));
#pragma unroll
        for (int k = 0; k < 4; ++k) hA[k] = (*(const u32x4*)(H + (size_t)t0 * DM + coff + 8 * k));
#pragma unroll
        for (int i = 0; i < 16; ++i) uvA[i] = *(const u32x4*)(Ubase + (((unsigned)eidN[i] << 7) + loff));
        ep = sel_eid + (size_t)t1 * 128 + g;
#pragma unroll
        for (int i = 0; i < 16; ++i) eidN[i] = (*(ep + 8 * i));
    }
#define TOKC(x) (widx + ((x) < ntok ? (x) : ntok - 1) * nw)
    for (int it = 0; it < ntok; it += 2) {
        {   const int t = TOKC(it), tn = TOKC(it + 1), tnn = TOKC(it + 2);
            peerA_step(uvA, uvB, hA, hB, eidN, Ubase, loff, H + (size_t)tn * DM + coff, sel_eid + (size_t)tnn * 128 + g, P + ((size_t)t * 8 + s) * 128, true, g, j); }
        {   const int t = TOKC(it + 1), tn = TOKC(it + 2), tnn = TOKC(it + 3);
            peerA_step(uvB, uvA, hB, hA, eidN, Ubase, loff, H + (size_t)tn * DM + coff, sel_eid + (size_t)tnn * 128 + g, P + ((size_t)t * 8 + s) * 128, it + 1 < ntok, g, j); }
    }
}
DI void peerC_phase(const float* __restrict__ P, const int* __restrict__ sel_eid, const float* __restrict__ sel_gate, const float* __restrict__ Us, const float* __restrict__ Vs, float* __restrict__ C, int bid, int nb) {
    const int lane = threadIdx.x & 63, w = threadIdx.x >> 6;
    for (int t = bid * 8 + w; t < TOK; t += nb * 8) {
        const float* pp = P + (size_t)t * 1024;
        float d0 = 0.f, d1 = 0.f;
#pragma unroll
        for (int s = 0; s < 8; ++s) { d0 += pp[s * 128 + lane]; d1 += pp[s * 128 + 64 + lane]; }
        const int e0 = sel_eid[(size_t)t * 128 + lane], e1 = sel_eid[(size_t)t * 128 + 64 + lane];
        C[(size_t)t * 128 + lane] = sel_gate[(size_t)t * 128 + lane] * Vs[e0] * gelu_f(d0 * Us[e0]);
        C[(size_t)t * 128 + 64 + lane] = sel_gate[(size_t)t * 128 + 64 + lane] * Vs[e1] * gelu_f(d1 * Us[e1]);
    }
}
DI void peerB_step(u32x4 (&cur)[16], u32x4 (&nxt)[16], const float (&cfcur)[16], float (&cfnxt)[16], int (&eidN)[16], const unsigned char* Vbase, unsigned loff,
                   const float* cpn, const int* epnn, bf16_t* op, bool do_store, bool b3) {
#pragma unroll
    for (int i = 0; i < 16; ++i) nxt[i] = *(const u32x4*)(Vbase + (((unsigned)eidN[i] << 7) + loff));
#pragma unroll
    for (int i = 0; i < 16; ++i) { eidN[i] = (*(epnn + 8 * i)); cfnxt[i] = (*(cpn + 8 * i)); }
    f32x2_t o[16];
#pragma unroll
    for (int k = 0; k < 16; ++k) o[k] = (f32x2_t){0.f, 0.f};
#pragma unroll
    for (int i = 0; i < 16; ++i) {
        const f32x2_t c2 = {cfcur[i], cfcur[i]};
#pragma unroll
        for (int k = 0; k < 4; ++k) {
            o[4 * k + 0] = FP4PAIR(cur[i][k], 0) * c2 + o[4 * k + 0]; o[4 * k + 1] = FP4PAIR(cur[i][k], 1) * c2 + o[4 * k + 1];
            o[4 * k + 2] = FP4PAIR(cur[i][k], 2) * c2 + o[4 * k + 2]; o[4 * k + 3] = FP4PAIR(cur[i][k], 3) * c2 + o[4 * k + 3];
        }
    }
    f32x2_t q8[8];
#pragma unroll
    for (int k = 0; k < 8; ++k) {
        const u32x2 sx = __builtin_amdgcn_permlane32_swap(__float_as_uint(o[k].x), __float_as_uint(o[8 + k].x), false, false);
        const u32x2 sy = __builtin_amdgcn_permlane32_swap(__float_as_uint(o[k].y), __float_as_uint(o[8 + k].y), false, false);
        q8[k] = (f32x2_t){__uint_as_float(sx.x) + __uint_as_float(sx.y), __uint_as_float(sy.x) + __uint_as_float(sy.y)};
    }
    f32x2_t q4[4];
#pragma unroll
    for (int k = 0; k < 4; ++k) {
        const u32x2 sx = __builtin_amdgcn_permlane16_swap(__float_as_uint(q8[k].x), __float_as_uint(q8[4 + k].x), false, false);
        const u32x2 sy = __builtin_amdgcn_permlane16_swap(__float_as_uint(q8[k].y), __float_as_uint(q8[4 + k].y), false, false);
        q4[k] = (f32x2_t){__uint_as_float(sx.x) + __uint_as_float(sx.y), __uint_as_float(sy.x) + __uint_as_float(sy.y)};
    }
    f32x4 fin;
#pragma unroll
    for (int k = 0; k < 2; ++k) {
        const f32x2_t keep = b3 ? q4[2 + k] : q4[k], send = b3 ? q4[k] : q4[2 + k];
        fin[2 * k] = keep.x + dpp_f<0x128>(send.x); fin[2 * k + 1] = keep.y + dpp_f<0x128>(send.y);
    }
    if (do_store) { u32x2 fo; fo.x = pk2(fin[0], fin[1]); fo.y = pk2(fin[2], fin[3]); __builtin_nontemporal_store(fo, (u32x2*)op); }
}
DI void peerB_phase(const unsigned char* __restrict__ V4, const int* __restrict__ sel_eid, const float* __restrict__ C, float* __restrict__ outpre, int bid, int nb) {
    const int lane = threadIdx.x & 63, w = threadIdx.x >> 6, g = lane >> 3, j = lane & 7;
    const int s = bid & 7, nxb = nb >> 3;
    if ((bid >> 3) >= nxb) return;
    const int widx = (bid >> 3) * 8 + w, nw = nxb * 8;
    const int ntok = (TOK - widx + nw - 1) / nw;
    const bool b5 = (lane & 32) != 0, b4 = (lane & 16) != 0, b3 = (lane & 8) != 0;
    const int qidx = (b5 ? 4 : 0) + (b4 ? 2 : 0) + (b3 ? 1 : 0);
    const size_t coff = (size_t)(256 * s + 32 * j) + 4 * qidx; const unsigned char* Vbase = V4 + (size_t)s * (16384 * 128); const unsigned loff = 16u * j;
    int eidN[16]; float cfA[16], cfB[16]; u32x4 vvA[16], vvB[16];
    {   const int t0 = widx, t1 = ntok > 1 ? widx + nw : widx;
        const int* ep = sel_eid + (size_t)t0 * 128 + g; const float* cp = C + (size_t)t0 * 128 + g;
#pragma unroll
        for (int i = 0; i < 16; ++i) { eidN[i] = (*(ep + 8 * i)); cfA[i] = (*(cp + 8 * i)); }
#pragma unroll
        for (int i = 0; i < 16; ++i) vvA[i] = *(const u32x4*)(Vbase + (((unsigned)eidN[i] << 7) + loff));
        ep = sel_eid + (size_t)t1 * 128 + g;
#pragma unroll
        for (int i = 0; i < 16; ++i) eidN[i] = (*(ep + 8 * i));
    }
    for (int it = 0; it < ntok; it += 2) {
        {   const int t = TOKC(it), tn = TOKC(it + 1), tnn = TOKC(it + 2);
            peerB_step(vvA, vvB, cfA, cfB, eidN, Vbase, loff, C + (size_t)tn * 128 + g, sel_eid + (size_t)tnn * 128 + g, (bf16_t*)(outpre + (size_t)t * DM) + coff, true, b3); }
        {   const int t = TOKC(it + 1), tn = TOKC(it + 2), tnn = TOKC(it + 3);
            peerB_step(vvB, vvA, cfB, cfA, eidN, Vbase, loff, C + (size_t)tn * 128 + g, sel_eid + (size_t)tnn * 128 + g, (bf16_t*)(outpre + (size_t)t * DM) + coff, it + 1 < ntok, b3); }
    }
#undef TOKC
}
DI void ln2_phase(const bf16_t* __restrict__ H, float* io, const float* __restrict__ g, const float* __restrict__ b, int bid, int nb) {
    const int lane = threadIdx.x & 63, w = threadIdx.x >> 6;
    for (int t = bid * 8 + w; t < TOK; t += nb * 8) {
        float v[32]; float s = 0.f;
#pragma unroll
        for (int i = 0; i < 4; ++i) {
            const int c0 = (lane + 64 * i) * 8;
            const u32x4 hv = *(const u32x4*)(H + (size_t)t * DM + c0);
            const u32x4 ov = *(const u32x4*)((const bf16_t*)(io + (size_t)t * DM) + c0);
            const f32x4 a = {bf_lo(ov.x), bf_hi(ov.x), bf_lo(ov.y), bf_hi(ov.y)}, c = {bf_lo(ov.z), bf_hi(ov.z), bf_lo(ov.w), bf_hi(ov.w)};
            v[8 * i + 0] = a[0] + ALPHA * bf_lo(hv[0]); v[8 * i + 1] = a[1] + ALPHA * bf_hi(hv[0]); v[8 * i + 2] = a[2] + ALPHA * bf_lo(hv[1]); v[8 * i + 3] = a[3] + ALPHA * bf_hi(hv[1]);
            v[8 * i + 4] = c[0] + ALPHA * bf_lo(hv[2]); v[8 * i + 5] = c[1] + ALPHA * bf_hi(hv[2]); v[8 * i + 6] = c[2] + ALPHA * bf_lo(hv[3]); v[8 * i + 7] = c[3] + ALPHA * bf_hi(hv[3]);
#pragma unroll
            for (int k = 0; k < 8; ++k) s += v[8 * i + k];
        }
        s = wave_sum(s); const float mu = s * (1.0f / 2048.0f); float q = 0.f;
#pragma unroll
        for (int k = 0; k < 32; ++k) { const float d = v[k] - mu; q += d * d; }
        q = wave_sum(q); const float rstd = rsqrtf(q * (1.0f / 2048.0f) + 1e-5f);
#pragma unroll
        for (int i = 0; i < 4; ++i) {
            const int c0 = (lane + 64 * i) * 8;
            const f32x4 ga = *(const f32x4*)(g + c0), gb = *(const f32x4*)(g + c0 + 4), ba = *(const f32x4*)(b + c0), bb = *(const f32x4*)(b + c0 + 4);
            f32x4 y0, y1;
#pragma unroll
            for (int k = 0; k < 4; ++k) { y0[k] = (v[8 * i + k] - mu) * rstd * ga[k] + ba[k]; y1[k] = (v[8 * i + 4 + k] - mu) * rstd * gb[k] + bb[k]; }
            *(f32x4*)(io + (size_t)t * DM + c0) = y0; *(f32x4*)(io + (size_t)t * DM + c0 + 4) = y1;
        }
    }
}

#define XB_TMO      128
#define XB_XCNT(j)  (256  + 64 * (j))
#define XB_XSUB(j)  (1280 + 64 * (j))
#define XB_XGEN(j)  (2304 + 64 * (j))
#define XB_TOP      3328
#define XB_TOPGEN   3392
#define XCD_BAR_WORDS 3456
#define XB_SPIN_CAP (1u << 18)
#define LAS __attribute__((address_space(3)))

__device__ __forceinline__ unsigned xb_ld(unsigned* p)              { return __hip_atomic_load(p, __ATOMIC_RELAXED, __HIP_MEMORY_SCOPE_AGENT); }
__device__ __forceinline__ unsigned xb_add(unsigned* p, unsigned v) { return __hip_atomic_fetch_add(p, v, __ATOMIC_RELAXED, __HIP_MEMORY_SCOPE_AGENT); }
__device__ __forceinline__ unsigned xb_xcc_id() { return (unsigned)__builtin_amdgcn_s_getreg((3 << 11) | 20) & 0xFu; }
#define XB_SPIN(cond, bar) do { unsigned _sp = 0; while (cond) { __builtin_amdgcn_s_sleep(1); \
    if ((++_sp & 255u) == 0u) { if (xb_ld(&(bar)[XB_TMO])) break; if (_sp > XB_SPIN_CAP) { atomicAdd(&(bar)[XB_TMO], 1u); break; } } } } while (0)

struct XcdBarrier {
    unsigned* bar; unsigned x;
    volatile LAS unsigned* st;
};

__device__ __forceinline__ XcdBarrier xcd_barrier_post(unsigned* bar, volatile LAS unsigned* st) {
    XcdBarrier b; b.bar = bar; b.x = xb_xcc_id(); b.st = st;
    if (threadIdx.x == 0) (void)xb_add(&bar[XB_XCNT(b.x)], 1u);
    return b;
}
__device__ __forceinline__ void xcd_barrier_complete(unsigned* bar, unsigned x, unsigned& nloc, unsigned& nx) {
    const unsigned G = gridDim.x * gridDim.y * gridDim.z;
    unsigned sum, cnt, mine, sp = 0u;
    for (;;) {
        sum = 0u; cnt = 0u; mine = 0u;
#pragma unroll
        for (unsigned j = 0; j < 16; ++j) { const unsigned c = xb_ld(&bar[XB_XCNT(j)]); sum += c; cnt += (c > 0u) ? 1u : 0u; mine = (j == x) ? c : mine; }
        if (sum == G) break;
        __builtin_amdgcn_s_sleep(1);
        if ((++sp & 255u) == 0u) { if (xb_ld(&bar[XB_TMO])) break; if (sp > XB_SPIN_CAP) { atomicAdd(&bar[XB_TMO], 1u); break; } }
    }
    nloc = mine > 0u ? mine : 1u; nx = cnt > 0u ? cnt : 1u;
}

__device__ __forceinline__ void xcd_barrier(const XcdBarrier& b) {
    asm volatile("s_waitcnt vmcnt(0)" ::: "memory");
    __syncthreads();
    if (threadIdx.x == 0) {
        unsigned* bar = b.bar;
        __builtin_amdgcn_s_waitcnt(0);
        unsigned nloc = b.st[0], nx = b.st[1];
        if (nloc == 0u) { xcd_barrier_complete(bar, b.x, nloc, nx); b.st[0] = nloc; b.st[1] = nx; }
        const unsigned old = xb_add(&bar[XB_XSUB(b.x)], 1u);
        const unsigned gen = old / nloc;
        if (old + 1u == (gen + 1u) * nloc) {
            __builtin_amdgcn_fence(__ATOMIC_RELEASE, "agent");
            asm volatile("s_waitcnt vmcnt(0)" ::: "memory");
            const unsigned og = xb_add(&bar[XB_TOP], 1u);
            const unsigned tg = og / nx;
            if (og + 1u == (tg + 1u) * nx) xb_add(&bar[XB_TOPGEN], 1u);
            else XB_SPIN(xb_ld(&bar[XB_TOPGEN]) == tg, bar);
            __builtin_amdgcn_fence(__ATOMIC_ACQUIRE, "agent");
            xb_add(&bar[XB_XGEN(b.x)], 1u);
            asm volatile("s_waitcnt vmcnt(0)" ::: "memory");
        } else {
            XB_SPIN(xb_ld(&bar[XB_XGEN(b.x)]) == gen, bar);
            __builtin_amdgcn_fence(__ATOMIC_ACQUIRE, "agent");
            asm volatile("s_waitcnt vmcnt(0)" ::: "memory");
        }
    }
    __syncthreads();
}

__global__ void __launch_bounds__(512) hymba_fwd(Params p) {
    extern __shared__ __attribute__((aligned(16))) unsigned char lds[];
    cg::grid_group grid = cg::this_grid();
    volatile LAS unsigned* bst = (volatile LAS unsigned*)(lds + 131072);
    if (threadIdx.x < 2) bst[threadIdx.x] = 0u;
    __syncthreads();
    const XcdBarrier xbar = xcd_barrier_post((unsigned*)(p.ws + WS_END + 131072), bst);
    const int bid = blockIdx.x, nb = gridDim.x;
    unsigned char* ws = p.ws;
    bf16_t* xb = (bf16_t*)(ws + WS_R0); bf16_t* mix = (bf16_t*)(ws + WS_R2);
    unsigned char* U8 = ws + WS_R0 + 96 * MiB; unsigned char* V8 = ws + WS_R0 + 112 * MiB; float* Us = (float*)(ws + WS_END); float* Vs = Us + 16384;
    bf16_t* Uc = (bf16_t*)(ws + WS_R1); bf16_t* BG = (bf16_t*)(ws + WS_R1 + 48 * MiB); bf16_t* Z = (bf16_t*)(ws + WS_R1);
    bf16_t* KVf = (bf16_t*)(ws + WS_R2); bf16_t* KVb = (bf16_t*)(ws + WS_R2 + 48 * MiB); bf16_t* H = (bf16_t*)(ws + WS_R2);
    bf16_t* Sf = (bf16_t*)(ws + WS_R3); bf16_t* Sb = (bf16_t*)(ws + WS_R3 + 48 * MiB);
    bf16_t* WinT = (bf16_t*)(ws + WS_W); bf16_t* WoutT = (bf16_t*)(ws + WS_W + 28 * MiB); bf16_t* WqkT = (bf16_t*)(ws + WS_W + 36 * MiB);
    bf16_t* Q = (bf16_t*)p.out; bf16_t* K = Q + (size_t)TOK * RW; bf16_t* V = K + (size_t)TOK * RW; bf16_t* G = V + (size_t)TOK * RW;

#ifndef PH_MASK
#define PH_MASK 0xFFFF
#endif
    if (PH_MASK & 1) {
    convert_flat(p.x_prompt, xb, (size_t)8192 * DM / 8, bid, nb);
    convert_flat(p.x_sample, xb + (size_t)8192 * DM, (size_t)16384 * DM / 8, bid, nb);
    transpose_convert<true>(p.w_in, NPROJ, WinT, NPROJ, bid, nb);
    transpose_convert<false>(p.w_out, DM, WoutT, DM, bid, nb);
    fold_phase(p.w_query, p.keys1, p.keys2, WqkT, lds, bid, nb);
    }
    if (p.ws == nullptr) grid.sync();
    xcd_barrier(xbar);
    if (PH_MASK & 2) {
        pg8::Gemm g{xb, WinT, TOK, NPROJ, DM}; pg8::StaticOrder S; S.init(TOK, NPROJ, nb, bid);
        EpiInProj E{Q, Uc, BG};
        pg8::gemm_phase<EpiInProj, pg8::StaticOrder, false>((PG8_LAS unsigned char*)lds, g, S, E, nullptr);
        const int rem = ((TOK / 256) * (NPROJ / 256)) % nb;
        if (rem) { if (bid >= rem) table_fp4_phase(p.peer_u, U8, Us, bid - rem, nb - rem); } else table_fp4_phase(p.peer_u, U8, Us, bid, nb);
    }
    xcd_barrier(xbar);
    if (PH_MASK & 4) r1_phase(K, V, KVf, KVb, p.rate_f, p.rate_b, lds, bid, nb);
    xcd_barrier(xbar);
    if (PH_MASK & 8) r2_phase(KVf, KVb, Sf, Sb, p.rate_f, p.rate_b, bid, nb);
    const int scan_wgs = (98304 + 511) / 512, vsplit = nb > scan_wgs ? 4096 : 0;
    if (vsplit && bid >= scan_wgs) table_fp4_phase(p.peer_v, V8, Vs, bid - scan_wgs, nb - scan_wgs, 0, vsplit);
    xcd_barrier(xbar);
    if (PH_MASK & 16) r3_phase(Q, K, V, G, Sf, Sb, p.rate_f, p.rate_b, p.gn_g, mix, lds, bid, nb);
    if (PH_MASK & 32) conv_phase(Uc, BG, p.conv_w, mix, bid, nb);
    xcd_barrier(xbar);
    if (PH_MASK & 64) {
        pg8::Gemm g{mix, WoutT, TOK, DM, DM}; pg8::StaticOrder S; S.init(TOK, DM, nb, bid);
        EpiOutProj E{Z};
        pg8::gemm_phase<EpiOutProj, pg8::StaticOrder, false>((PG8_LAS unsigned char*)lds, g, S, E, nullptr);
    }
    xcd_barrier(xbar);
    if (PH_MASK & 128) ln1_phase(Z, xb, p.ln1_g, p.ln1_b, H, bid, nb);
    table_fp4_phase(p.peer_v, V8, Vs, bid, nb, vsplit, 16384);
    xcd_barrier(xbar);
    if (PH_MASK & 256) {
        pg8::Gemm g{H, WqkT, TOK, DM, DM}; pg8::StaticOrder S; S.init(TOK, DM, nb, bid);
        EpiScore E{(bf16_t*)p.out};
        pg8::gemm_phase<EpiScore, pg8::StaticOrder, false>((PG8_LAS unsigned char*)lds, g, S, E, nullptr);
    }
    xcd_barrier(xbar);
    {
        int* sel_eid = (int*)(ws + WS_R1); float* sel_gate = (float*)(ws + WS_R1 + 16 * MiB); float* Cf = (float*)(ws + WS_R1 + 32 * MiB);
        route_phase(p.out, sel_eid, sel_gate, lds, bid, nb);
        xcd_barrier(xbar);
        peerA_phase(H, U8, sel_eid, p.out, bid, nb);
        xcd_barrier(xbar);
        peerC_phase(p.out, sel_eid, sel_gate, Us, Vs, Cf, bid, nb);
        xcd_barrier(xbar);
        peerB_phase(V8, sel_eid, Cf, p.out, bid, nb);
        xcd_barrier(xbar);
        ln2_phase(H, p.out, p.ln2_g, p.ln2_b, bid, nb);
    }
}

extern "C" void kernel_launch(void* const* d_in, const int* in_sizes, int n_in, void* d_out, int out_size, void* d_ws, size_t ws_size, hipStream_t stream) {
    constexpr int LDS_BYTES = 131072 + 16;
    static int grid_blocks = 0;
    if (!grid_blocks) {
        int dev = 0, cus = 0, per_cu = 0;
        hipGetDevice(&dev);
        hipDeviceGetAttribute(&cus, hipDeviceAttributeMultiprocessorCount, dev);
        hipFuncSetAttribute((const void*)hymba_fwd, hipFuncAttributeMaxDynamicSharedMemorySize, LDS_BYTES);
        hipOccupancyMaxActiveBlocksPerMultiprocessor(&per_cu, (const void*)hymba_fwd, 512, LDS_BYTES);
        if (per_cu < 1) per_cu = 1;
        grid_blocks = cus * per_cu;
        if (ws_size < WS_END + 131072 + XCD_BAR_WORDS * 4) fprintf(stderr, "kernel_launch: workspace too small: %zu < %zu\n", ws_size, (size_t)WS_END);
    }
    (void)hipMemsetAsync((unsigned char*)d_ws + WS_END + 131072, 0, XCD_BAR_WORDS * 4, stream);
    Params p{};
    const float** pp = (const float**)&p;
    for (int i = 0; i < 17; ++i) pp[i] = (const float*)d_in[i];
    p.out = (float*)d_out; p.ws = (unsigned char*)d_ws;
    void* args[] = {&p};
    hipError_t e = hipLaunchCooperativeKernel((const void*)hymba_fwd, dim3(grid_blocks), dim3(512), args, LDS_BYTES, stream);
    if (e != hipSuccess) fprintf(stderr, "cooperative launch failed: %s (grid %d)\n", hipGetErrorString(e), grid_blocks);
}
```
